# Optimizing an MI355X kernel written in HIP

```python
import jax, jax.numpy as jnp
from jax import lax
import numpy as np

D_MODEL = 4096
BATCH = 4
SEQ = 2048
DEPTH = 2

HEAD_DIM = 128
ROPE_THETA = 10000.0
NORM_EPS = 1e-6
PLE_DIM = 256
NEG_INF = -1e30

SWA_HEADS = 12
SWA_KV_HEADS = 4
SWA_GROUP = SWA_HEADS // SWA_KV_HEADS
SWA_WINDOW = 128
SWA_BLOCK = 128
SWA_OUT = SWA_HEADS * HEAD_DIM

RG_WIDTH = 1024
RG_BLOCKS = 8
RG_BLOCK_DIM = RG_WIDTH // RG_BLOCKS
RG_CONV = 4
RG_C = 8.0

MLA_HEADS = 12
MLA_Q_RANK = 1024
MLA_KV_RANK = 512
MLA_NOPE = 128
MLA_ROPE = 64
MLA_V = 128
MLA_QBLOCK = 128
MLA_OUT = MLA_HEADS * MLA_V

MIX_WIDTH = SWA_OUT + RG_WIDTH + MLA_OUT

IN_SIZES = (SWA_OUT, SWA_KV_HEADS * HEAD_DIM, SWA_KV_HEADS * HEAD_DIM,
            RG_WIDTH, RG_WIDTH, MLA_Q_RANK, MLA_KV_RANK, MLA_ROPE)
IN_WIDTH = sum(IN_SIZES)
IN_SPLITS = tuple(int(v) for v in np.cumsum(IN_SIZES)[:-1])

D_FF = -(-8 * D_MODEL // (3 * 256)) * 256

kernel_name = 'hybrid_parallel_heads_swa_rglru_mla'


def rmsnorm(x, g):
    xf = x.astype(jnp.float32)
    y = xf * lax.rsqrt(jnp.mean(xf * xf, axis=-1, keepdims=True) + NORM_EPS)
    return (y * g.astype(jnp.float32)).astype(x.dtype)


def rope(x, positions):
    d = x.shape[-1]
    inv = ROPE_THETA ** (-jnp.arange(0, d, 2, dtype=jnp.float32) / d)
    ang = positions.astype(jnp.float32)[:, :, None] * inv
    cos = jnp.cos(ang)[:, :, None, :]
    sin = jnp.sin(ang)[:, :, None, :]
    xf = x.astype(jnp.float32)
    x1, x2 = jnp.split(xf, 2, axis=-1)
    return jnp.concatenate([x1 * cos - x2 * sin, x2 * cos + x1 * sin], axis=-1).astype(x.dtype)


def swa_attention(q, k, v, sinks):
    B, S = q.shape[0], q.shape[1]
    L = SWA_BLOCK
    nb = S // L
    qb = q.reshape(B, nb, L, SWA_KV_HEADS, SWA_GROUP, HEAD_DIM)

    def with_prev(t):
        t = t.reshape(B, nb, L, SWA_KV_HEADS, HEAD_DIM)
        prev = jnp.pad(t[:, :-1], ((0, 0), (1, 0), (0, 0), (0, 0), (0, 0)))
        return jnp.concatenate([prev, t], axis=2)

    kk, vv = with_prev(k), with_prev(v)
    scores = jnp.einsum('bnqkgd,bnskd->bnkgqs', qb, kk,
                        preferred_element_type=jnp.float32) * (HEAD_DIM ** -0.5)
    blk = jnp.arange(nb)[:, None, None]
    qpos = blk * L + jnp.arange(L)[None, :, None]
    kpos = (blk - 1) * L + jnp.arange(2 * L)[None, None, :]
    valid = (kpos >= 0) & (kpos <= qpos) & (qpos - kpos < SWA_WINDOW)
    scores = jnp.where(valid[None, :, None, None], scores, NEG_INF)
    sink = sinks.astype(jnp.float32).reshape(SWA_KV_HEADS, SWA_GROUP)[None, None, :, :, None, None]
    sink = jnp.broadcast_to(sink, scores.shape[:-1] + (1,))
    probs = jax.nn.softmax(jnp.concatenate([scores, sink], axis=-1), axis=-1)[..., :-1]
    out = jnp.einsum('bnkgqs,bnskd->bnqkgd', probs.astype(v.dtype), vv)
    return out.reshape(B, S, SWA_OUT)


def rglru(xr, conv_w, conv_b, wa, ba, wx, bx, lam):
    B, S = xr.shape[0], xr.shape[1]
    xc = lax.conv_general_dilated(xr, conv_w[:, None, :], window_strides=(1,),
                                  padding=[(RG_CONV - 1, 0)],
                                  dimension_numbers=('NWC', 'WIO', 'NWC'),
                                  feature_group_count=RG_WIDTH) + conv_b
    xg = xc.reshape(B, S, RG_BLOCKS, RG_BLOCK_DIM)
    r = jax.nn.sigmoid((jnp.einsum('bsnc,ncd->bsnd', xg, wa).reshape(B, S, RG_WIDTH) + ba).astype(jnp.float32))
    i = jax.nn.sigmoid((jnp.einsum('bsnc,ncd->bsnd', xg, wx).reshape(B, S, RG_WIDTH) + bx).astype(jnp.float32))
    log_a = -RG_C * jax.nn.softplus(-lam.astype(jnp.float32)) * r
    a = jnp.exp(log_a)
    b = jnp.sqrt(-jnp.expm1(2.0 * log_a)) * i * xc.astype(jnp.float32)

    def combine(left, right):
        a1, b1 = left
        a2, b2 = right
        return a1 * a2, a2 * b1 + b2

    _, h = lax.associative_scan(combine, (a, b), axis=1)
    return h.astype(xr.dtype)


def mla_attention(cq, ckv, kr, positions, q_norm, w_uq, kv_norm, w_ukv):
    B, S = cq.shape[0], cq.shape[1]
    q = (rmsnorm(cq, q_norm) @ w_uq).reshape(B, S, MLA_HEADS, MLA_NOPE + MLA_ROPE)
    q_nope = q[..., :MLA_NOPE]
    q_rope = rope(q[..., MLA_NOPE:], positions)
    kv = (rmsnorm(ckv, kv_norm) @ w_ukv).reshape(B, S, MLA_HEADS, MLA_NOPE + MLA_V)
    k_nope, v = kv[..., :MLA_NOPE], kv[..., MLA_NOPE:]
    k_rope = rope(kr[:, :, None, :], positions)[:, :, 0]
    scale = (MLA_NOPE + MLA_ROPE) ** -0.5
    outs = []
    for j in range(S // MLA_QBLOCK):
        q0 = j * MLA_QBLOCK
        end = q0 + MLA_QBLOCK
        s = (jnp.einsum('bqhd,bkhd->bhqk', q_nope[:, q0:end], k_nope[:, :end],
                        preferred_element_type=jnp.float32)
             + jnp.einsum('bqhd,bkd->bhqk', q_rope[:, q0:end], k_rope[:, :end],
                          preferred_element_type=jnp.float32)) * scale
        causal = jnp.arange(end)[None, :] <= (q0 + jnp.arange(MLA_QBLOCK))[:, None]
        s = jnp.where(causal, s, NEG_INF)
        pr = jax.nn.softmax(s, axis=-1).astype(v.dtype)
        outs.append(jnp.einsum('bhqk,bkhd->bqhd', pr, v[:, :end]))
    return jnp.concatenate(outs, axis=1).reshape(B, S, MLA_OUT)


def setup_inputs(seed: int = 0) -> dict:
    key = jax.random.key(seed)
    ks = iter(jax.random.split(key, 40))

    def nrm(shape, scale):
        return jax.random.normal(next(ks), shape, jnp.float32) * scale

    def gain(n):
        return 1.0 + 0.05 * nrm((DEPTH, n), 1.0)

    x = nrm((BATCH, SEQ, D_MODEL), 1.0)
    p = nrm((DEPTH, BATCH, SEQ, PLE_DIM), 1.0)
    offset = jax.random.randint(next(ks), (BATCH,), 0, 4096, dtype=jnp.int32)
    positions = offset[:, None] + jnp.arange(SEQ, dtype=jnp.int32)[None, :]
    u = jax.random.uniform(next(ks), (DEPTH, RG_WIDTH), jnp.float32, 0.9, 0.999)
    a_base = u ** (1.0 / RG_C)
    rg_lambda = jnp.log(a_base) - jnp.log1p(-a_base)
    return {
        'x': x,
        'p': p,
        'positions': positions,
        'pre_mix_norm': gain(D_MODEL),
        'w_in': nrm((DEPTH, D_MODEL, IN_WIDTH), D_MODEL ** -0.5),
        'swa_sinks': nrm((DEPTH, SWA_HEADS), 1.0),
        'rg_conv_w': nrm((DEPTH, RG_CONV, RG_WIDTH), RG_CONV ** -0.5),
        'rg_conv_b': nrm((DEPTH, RG_WIDTH), 0.02),
        'rg_gate_a_w': nrm((DEPTH, RG_BLOCKS, RG_BLOCK_DIM, RG_BLOCK_DIM), RG_BLOCK_DIM ** -0.5),
        'rg_gate_a_b': nrm((DEPTH, RG_WIDTH), 0.1),
        'rg_gate_x_w': nrm((DEPTH, RG_BLOCKS, RG_BLOCK_DIM, RG_BLOCK_DIM), RG_BLOCK_DIM ** -0.5),
        'rg_gate_x_b': nrm((DEPTH, RG_WIDTH), 0.1),
        'rg_lambda': rg_lambda,
        'mla_q_norm': gain(MLA_Q_RANK),
        'mla_w_uq': nrm((DEPTH, MLA_Q_RANK, MLA_HEADS * (MLA_NOPE + MLA_ROPE)), MLA_Q_RANK ** -0.5),
        'mla_kv_norm': gain(MLA_KV_RANK),
        'mla_w_ukv': nrm((DEPTH, MLA_KV_RANK, MLA_HEADS * (MLA_NOPE + MLA_V)), MLA_KV_RANK ** -0.5),
        'group_norm': gain(MIX_WIDTH),
        'w_out': nrm((DEPTH, MIX_WIDTH, D_MODEL), MIX_WIDTH ** -0.5),
        'post_mix_norm': gain(D_MODEL),
        'pre_ffn_norm': gain(D_MODEL),
        'w_gate': nrm((DEPTH, D_MODEL, D_FF), D_MODEL ** -0.5),
        'w_up': nrm((DEPTH, D_MODEL, D_FF), D_MODEL ** -0.5),
        'w_down': nrm((DEPTH, D_FF, D_MODEL), D_FF ** -0.5),
        'post_ffn_norm': gain(D_MODEL),
        'w_ple': nrm((DEPTH, PLE_DIM, D_MODEL), PLE_DIM ** -0.5),
        'ple_norm': gain(D_MODEL),
        'w_ple_gate': nrm((DEPTH, D_MODEL, D_MODEL), D_MODEL ** -0.5),
        'b_ple_gate': nrm((DEPTH, D_MODEL), 0.1),
    }


def reference(x, p, positions, pre_mix_norm, w_in, swa_sinks, rg_conv_w, rg_conv_b,
              rg_gate_a_w, rg_gate_a_b, rg_gate_x_w, rg_gate_x_b, rg_lambda,
              mla_q_norm, mla_w_uq, mla_kv_norm, mla_w_ukv, group_norm, w_out,
              post_mix_norm, pre_ffn_norm, w_gate, w_up, w_down, post_ffn_norm,
              w_ple, ple_norm, w_ple_gate, b_ple_gate):
    B, S = x.shape[0], x.shape[1]
    for i in range(DEPTH):
        h = rmsnorm(x, pre_mix_norm[i])
        z = h @ w_in[i]
        q_a, k_a, v_a, x_r, g_r, c_q, c_kv, k_r = jnp.split(z, IN_SPLITS, axis=-1)
        q_a = rope(q_a.reshape(B, S, SWA_HEADS, HEAD_DIM), positions)
        k_a = rope(k_a.reshape(B, S, SWA_KV_HEADS, HEAD_DIM), positions)
        v_a = v_a.reshape(B, S, SWA_KV_HEADS, HEAD_DIM)
        o_a = swa_attention(q_a, k_a, v_a, swa_sinks[i])
        o_b = rglru(x_r, rg_conv_w[i], rg_conv_b[i], rg_gate_a_w[i], rg_gate_a_b[i],
                    rg_gate_x_w[i], rg_gate_x_b[i], rg_lambda[i]) * jax.nn.gelu(g_r)
        o_c = mla_attention(c_q, c_kv, k_r, positions, mla_q_norm[i], mla_w_uq[i],
                            mla_kv_norm[i], mla_w_ukv[i])
        gn = group_norm[i]
        mixed = jnp.concatenate([
            rmsnorm(o_a, gn[:SWA_OUT]),
            rmsnorm(o_b, gn[SWA_OUT:SWA_OUT + RG_WIDTH]),
            rmsnorm(o_c, gn[SWA_OUT + RG_WIDTH:]),
        ], axis=-1)
        x = x + rmsnorm(mixed @ w_out[i], post_mix_norm[i])
        h = rmsnorm(x, pre_ffn_norm[i])
        f = (jax.nn.silu(h @ w_gate[i]) * (h @ w_up[i])) @ w_down[i]
        x = x + rmsnorm(f, post_ffn_norm[i])
        e = rmsnorm(p[i] @ w_ple[i], ple_norm[i])
        x = x + jax.nn.sigmoid(x @ w_ple_gate[i] + b_ple_gate[i]) * e
    return x
```

```cpp
#include <hip/hip_runtime.h>
#include <cstdio>
#include <cstdint>
#include <cmath>

#ifndef MK_N_LAUNCHES
#define MK_N_LAUNCHES 1
#endif

#ifndef PROBE_REPEAT
#define PROBE_REPEAT -1
#endif
#define REP(k) ((PROBE_REPEAT == (k)) ? 2 : 1)
#define LAS __attribute__((address_space(3)))
#define GAS __attribute__((address_space(1)))
typedef unsigned short bf16_t;
typedef short bf16x8 __attribute__((ext_vector_type(8)));
typedef short s16x4 __attribute__((ext_vector_type(4)));
typedef float f32x4 __attribute__((ext_vector_type(4)));
typedef float f32x2 __attribute__((ext_vector_type(2)));
typedef float f32x16 __attribute__((ext_vector_type(16)));
typedef unsigned u32x4 __attribute__((ext_vector_type(4)));
typedef unsigned u32x2 __attribute__((ext_vector_type(2)));

constexpr int NB = 4, SEQ = 2048, M = NB * SEQ, DM = 4096, DEPTH = 2;
constexpr int NZ = 6208, NZP = 6400, DFF = 11008, NGU = 2 * DFF, PLE = 256;
constexpr int NQU = 2304, NKVU = 3072, QRANK = 1024, KVRANK = 512, RGW = 1024;
constexpr float EPS = 1e-6f;
constexpr int NIN = 29;

constexpr size_t al4k(size_t x) { return (x + 4095) & ~(size_t)4095; }
constexpr size_t WS_CTL = 0, CTL_BYTES = 1u << 20;
constexpr size_t WO_Z = 0;
constexpr size_t WO_KR = WO_Z + (size_t)6144 * DM * 2;
constexpr size_t WO_UQ = WO_Z + (size_t)NZP * DM * 2;
static_assert(WO_KR + (size_t)8 * 256 * 512 * 2 <= WO_UQ, "k_r slices fit behind the main z copy");
constexpr size_t WO_UKV = WO_UQ + (size_t)NQU * QRANK * 2;
constexpr size_t WO_RG = WO_UKV + (size_t)NKVU * KVRANK * 2;
constexpr size_t WO_OUT = WO_RG + (size_t)2048 * 128 * 2;
constexpr size_t WO_GU = WO_OUT + (size_t)DM * DM * 2;
constexpr size_t WO_DN = WO_GU + (size_t)NGU * DM * 2;
constexpr size_t WO_PLE = WO_DN + (size_t)DM * DFF * 2;
constexpr size_t WO_PG = WO_PLE + (size_t)DM * PLE * 2;
constexpr size_t W_LAYER = al4k(WO_PG + (size_t)DM * DM * 2);
constexpr size_t WS_W = WS_CTL + CTL_BYTES;
constexpr size_t WS_R1 = WS_W + 2 * W_LAYER;
constexpr size_t R1_QA = 0, R1_KA = R1_QA + (size_t)M * 1536 * 2, R1_VA = R1_KA + (size_t)M * 512 * 2, R1_XR = R1_VA + (size_t)M * 512 * 2;
constexpr size_t R1_GG = R1_XR + (size_t)M * 1024 * 2, R1_CQ = R1_GG + (size_t)M * 1024 * 2, R1_CKV = R1_CQ + (size_t)M * 1024 * 2, R1_KR = R1_CKV + (size_t)M * 512 * 2;
constexpr size_t R1_QN = R1_KR + (size_t)M * 64 * 2, R1_QR = R1_QN + (size_t)M * 1536 * 2, R1_XC = R1_QR + (size_t)M * 768 * 2, R1_END = R1_XC + (size_t)M * 1024 * 2;
constexpr size_t R1_BYTES = al4k((size_t)M * DFF * 2);
static_assert(R1_END <= R1_BYTES, "R1 overlay");
constexpr size_t WS_R2 = WS_R1 + R1_BYTES;
constexpr size_t R2_KVM = 0, R2_AA = R2_KVM + (size_t)M * NKVU * 2, R2_BB = R2_AA + (size_t)M * 1024 * 4, R2_END = R2_BB + (size_t)M * 1024 * 4;
constexpr size_t R2_BYTES = (size_t)M * DM * 4;
static_assert(R2_END + (size_t)8 * M * 64 * 4 <= R2_BYTES, "R2 overlay + k_r partials");
constexpr size_t WS_OC = WS_R2 + R2_BYTES;
constexpr size_t WS_MIX = WS_OC + (size_t)M * DM * 2;
constexpr size_t WS_GSS = WS_MIX;
constexpr size_t WS_RT = WS_GSS + (size_t)M * 40 * 4;
constexpr size_t WS_XB = WS_MIX + (size_t)M * DM * 2;
constexpr size_t WS_ERAW = WS_XB + (size_t)M * DM * 2;
constexpr size_t WS_SSQ24 = WS_ERAW + (size_t)M * DM * 4;
constexpr size_t WS_SSQ64 = WS_SSQ24 + (size_t)M * 24 * 4;
constexpr size_t WS_ESSQ = WS_SSQ64 + (size_t)M * 64 * 4;
constexpr size_t WS_RSTD = WS_ESSQ + (size_t)M * 64 * 4;
constexpr size_t WS_ESC = WS_RSTD + (size_t)M * 4;
constexpr size_t WS_CP = WS_ESC + (size_t)M * 4;
constexpr size_t WS_CL = WS_CP + (size_t)NB * 32 * 1024 * 4;
constexpr size_t WS_COS128 = WS_CL + (size_t)NB * 32 * 1024 * 4;
constexpr size_t WS_SIN128 = WS_COS128 + (size_t)M * 64 * 4;
constexpr size_t WS_COS64 = WS_SIN128 + (size_t)M * 64 * 4;
constexpr size_t WS_SIN64 = WS_COS64 + (size_t)M * 32 * 4;
constexpr size_t WS_PB = WS_SIN64 + (size_t)M * 32 * 4;
constexpr size_t WS_C8 = WS_PB + (size_t)DEPTH * M * PLE * 2;
constexpr size_t WS_END = al4k(WS_C8 + (size_t)DEPTH * RGW * 4);

constexpr int CW_BAR = 4096;
constexpr int CW_Q = 16384;

constexpr int RING_BYTES = 131072;
constexpr int MISC_OFF = RING_BYTES + 320;
constexpr int LDS_BYTES = 147456;

__device__ __forceinline__ unsigned cvt_pk_bf16(float lo, float hi) { unsigned r; asm("v_cvt_pk_bf16_f32 %0, %1, %2" : "=v"(r) : "v"(lo), "v"(hi)); return r; }
__device__ __forceinline__ float bf2f(unsigned short b) { return __uint_as_float(((unsigned)b) << 16); }
__device__ __forceinline__ float bflo(unsigned w) { return __uint_as_float(w << 16); }
__device__ __forceinline__ float bfhi(unsigned w) { return __uint_as_float(w & 0xffff0000u); }
__device__ __forceinline__ float wave_sum(float v) {
#pragma unroll
    for (int o = 1; o < 64; o <<= 1) v += __shfl_xor(v, o);
    return v;
}
template <int N, int LEN>
__device__ __forceinline__ void rs_step(float (&v)[LEN], bool up, int mask) {
#pragma unroll
    for (int i = 0; i < N; ++i) { const float send = up ? v[i] : v[i + N], keep = up ? v[i + N] : v[i]; v[i] = keep + __shfl_xor(send, mask); }
}
__device__ __forceinline__ float dot4(f32x4 v) { return (v.x * v.x + v.y * v.y) + (v.z * v.z + v.w * v.w); }
__device__ __forceinline__ float sigmoidf_(float x) { return __builtin_amdgcn_rcpf(1.0f + __builtin_amdgcn_exp2f(-1.4426950408889634f * x)); }
__device__ __forceinline__ float gelu_tanh(float x) { const float u = 0.7978845608028654f * (x + 0.044715f * x * x * x); return x * sigmoidf_(2.0f * u); }
__device__ __forceinline__ int otid(int wv) { int l = (int)__builtin_amdgcn_mbcnt_hi(~0u, __builtin_amdgcn_mbcnt_lo(~0u, 0u)); asm volatile("" : "+v"(l)); return (wv << 6) | l; }
__device__ __forceinline__ unsigned char* oweak(unsigned char* p) { size_t z = 0; asm volatile("" : "+s"(z)); return p + z; }
#define LDS_WAIT() asm volatile("s_waitcnt lgkmcnt(0)" ::: "memory")
#define VM_WAIT() asm volatile("s_waitcnt vmcnt(0)" ::: "memory")

#define XB_TMO      128
#define XB_XCNT(j)  (256  + 64 * (j))
#define XB_XSUB(j)  (1280 + 64 * (j))
#define XB_XGEN(j)  (2304 + 64 * (j))
#define XB_TOP      3328
#define XB_TOPGEN   3392
#define XCD_BAR_WORDS 3456
#define XB_SPIN_CAP (1u << 18)
__device__ __forceinline__ unsigned xb_ld(unsigned* p)              { return __hip_atomic_load(p, __ATOMIC_RELAXED, __HIP_MEMORY_SCOPE_AGENT); }
__device__ __forceinline__ unsigned xb_add(unsigned* p, unsigned v) { return __hip_atomic_fetch_add(p, v, __ATOMIC_RELAXED, __HIP_MEMORY_SCOPE_AGENT); }
__device__ __forceinline__ unsigned xb_xcc_id() { return (unsigned)__builtin_amdgcn_s_getreg((3 << 11) | 20) & 0xFu; }
#define XB_SPIN(cond, bar) do { unsigned _sp = 0; while (cond) { __builtin_amdgcn_s_sleep(1); \
    if ((++_sp & 255u) == 0u) { if (xb_ld(&(bar)[XB_TMO])) break; if (_sp > XB_SPIN_CAP) { atomicAdd(&(bar)[XB_TMO], 1u); break; } } } } while (0)
struct XcdBarrier { unsigned* bar; unsigned x; volatile LAS unsigned* st; };
__device__ __forceinline__ XcdBarrier xcd_barrier_post(unsigned* bar, volatile LAS unsigned* st) {
    XcdBarrier b; b.bar = bar; b.x = xb_xcc_id(); b.st = st;
    if (threadIdx.x == 0) (void)xb_add(&bar[XB_XCNT(b.x)], 1u);
    return b;
}
__device__ __forceinline__ void xcd_barrier_complete(unsigned* bar, unsigned x, unsigned& nloc, unsigned& nx) {
    const unsigned G = gridDim.x * gridDim.y * gridDim.z;
    unsigned sum, cnt, mine, sp = 0u;
    for (;;) {
        sum = 0u; cnt = 0u; mine = 0u;
#pragma unroll
        for (unsigned j = 0; j < 16; ++j) { const unsigned c = xb_ld(&bar[XB_XCNT(j)]); sum += c; cnt += (c > 0u) ? 1u : 0u; mine = (j == x) ? c : mine; }
        if (sum == G) break;
        __builtin_amdgcn_s_sleep(1);
        if ((++sp & 255u) == 0u) { if (xb_ld(&bar[XB_TMO])) break; if (sp > XB_SPIN_CAP) { atomicAdd(&bar[XB_TMO], 1u); break; } }
    }
    nloc = mine > 0u ? mine : 1u; nx = cnt > 0u ? cnt : 1u;
}
__device__ __forceinline__ void xcd_barrier(const XcdBarrier& b) {
    asm volatile("s_waitcnt vmcnt(0)" ::: "memory");
    __syncthreads();
    if (threadIdx.x == 0) {
        unsigned* bar = b.bar;
        __builtin_amdgcn_s_waitcnt(0);
        unsigned nloc = b.st[0], nx = b.st[1];
        if (nloc == 0u) { xcd_barrier_complete(bar, b.x, nloc, nx); b.st[0] = nloc; b.st[1] = nx; }
        const unsigned old = xb_add(&bar[XB_XSUB(b.x)], 1u);
        const unsigned gen = old / nloc;
        if (old + 1u == (gen + 1u) * nloc) {
            __builtin_amdgcn_fence(__ATOMIC_RELEASE, "agent");
            asm volatile("s_waitcnt vmcnt(0)" ::: "memory");
            const unsigned og = xb_add(&bar[XB_TOP], 1u);
            const unsigned tg = og / nx;
            if (og + 1u == (tg + 1u) * nx) xb_add(&bar[XB_TOPGEN], 1u);
            else XB_SPIN(xb_ld(&bar[XB_TOPGEN]) == tg, bar);
            __builtin_amdgcn_fence(__ATOMIC_ACQUIRE, "agent");
            xb_add(&bar[XB_XGEN(b.x)], 1u);
            asm volatile("s_waitcnt vmcnt(0)" ::: "memory");
        } else {
            XB_SPIN(xb_ld(&bar[XB_XGEN(b.x)]) == gen, bar);
            __builtin_amdgcn_fence(__ATOMIC_ACQUIRE, "agent");
            asm volatile("s_waitcnt vmcnt(0)" ::: "memory");
        }
    }
    __syncthreads();
}

namespace pg8 {
constexpr int BM = 256, BK = 64, HALF = 128, HTB = HALF * BK * 2, NXCD = 8, WGM = 8;
__host__ __device__ __forceinline__ int lds_byte(int r, int c) { const int st = (r >> 4) * 2 + (c >> 5), rr = r & 15, cc = c & 31, ob = rr * 64 + cc * 2; return st * 1024 + (ob ^ (((ob >> 9) & 1) << 5)); }
__host__ __device__ __forceinline__ void stage_rc(int b, int& R, int& C) { const int st = b / 1024, sb = b % 1024, swz = sb ^ (((sb >> 9) & 1) << 5); R = (st >> 1) * 16 + swz / 64; C = (st & 1) * 32 + (swz % 64) / 2; }

struct Prob { const bf16_t* A; const bf16_t* Bt; int lda, ldb, K, nN, a_pn; };
constexpr int NM = M / BM;
struct Unit { int p, pm, pn; const char* A; const char* B; int lda2, ldb2, nt; };

template <int NP>
struct Deal {
    Prob P0, P1, P2; int G, c, n0, n1, n2, T; unsigned rev = 0;
    __device__ __forceinline__ void init(const Prob& a, const Prob& b, const Prob& d, int G_, int c_) { P0 = a; P1 = b; P2 = d; G = G_; c = c_; n0 = NM * a.nN; n1 = NP > 1 ? NM * b.nN : 0; n2 = NP > 2 ? NM * d.nN : 0; T = n0 + n1 + n2; }
};
template <int NP>
__device__ __forceinline__ bool deal_next(const Deal<NP> S, int i, Unit& u) {
    {
        const Prob P0 = S.P0, P1 = S.P1, P2 = S.P2; const int G = S.G, c = S.c, n0 = S.n0, n1 = S.n1, n2 = S.n2, T = S.T;
        const int L = i * G + (((S.rev >> i) & 1u) ? G - 1 - c : c); if (L >= T) return false;
        int p = 0, l = L, nw = n0;
        if (NP > 1 && L >= n0) { p = 1; l = L - n0; nw = n1; }
        if (NP > 2 && L >= n0 + n1) { p = 2; l = L - n0 - n1; nw = n2; }
#define PG8_PICK(f) ((NP == 1 || p == 0) ? P0.f : ((NP == 2 || p == 1) ? P1.f : P2.f))
        const int nN = PG8_PICK(nN);
        int wgid = l; { const int q = nw / NXCD, r = nw % NXCD, xcd = wgid % NXCD, off = wgid / NXCD; wgid = (xcd < r ? xcd * (q + 1) : r * (q + 1) + (xcd - r) * q) + off; }
        const int nig = WGM * nN, gid = wgid / nig, fm = gid * WGM, gsz = (NM - fm) < WGM ? (NM - fm) : WGM;
        u.p = p; u.pm = fm + ((wgid % nig) % gsz); u.pn = (wgid % nig) / gsz;
        u.lda2 = PG8_PICK(lda) * 2; u.ldb2 = PG8_PICK(ldb) * 2; u.nt = PG8_PICK(K) / BK;
        u.lda2 = __builtin_amdgcn_readfirstlane(u.lda2); u.ldb2 = __builtin_amdgcn_readfirstlane(u.ldb2); u.nt = __builtin_amdgcn_readfirstlane(u.nt);
        asm volatile("" : "+s"(u.lda2), "+s"(u.ldb2), "+s"(u.nt));
        u.A = (const char*)PG8_PICK(A) + (size_t)u.pm * BM * u.lda2 + (size_t)u.pn * PG8_PICK(a_pn) * 2;
        u.B = (const char*)PG8_PICK(Bt) + (size_t)u.pn * BM * u.ldb2;
#undef PG8_PICK
        return true;
    }
}

template <int NP, class Epi>
__device__ __forceinline__ void gemm_phase(LAS unsigned char* lds, int wv, const Deal<NP> S, const Epi E) {
    const int tid = otid(wv), wid = __builtin_amdgcn_readfirstlane(tid >> 6), lane = tid & 63, wr = wid >> 2, wc = wid & 3, fr = lane & 15, fq = lane >> 4;
    int R0, C0; stage_rc(tid * 16, R0, C0);
    const unsigned c0b = (unsigned)C0 * 2u;
    const unsigned ldsw = (unsigned)wid * 1024u;
    const int aoff = lds_byte(wr * 64 + fr, fq * 8), boff = lds_byte(wc * 32 + fr, fq * 8);
#define PG8_SA(b, h) (((b) * 2 + (h)) * HTB)
#define PG8_SB(b, h) ((4 + (b) * 2 + (h)) * HTB)
#define PG8_STAGE(bufoff, gbase, ld2) do { const unsigned _vo = (unsigned)R0 * (unsigned)(ld2) + c0b; const char* _g = (const char*)(gbase); \
        __builtin_amdgcn_global_load_lds((const unsigned*)(_g + _vo), (LAS unsigned*)(lds + (bufoff) + ldsw), 16, 0, 0); \
        __builtin_amdgcn_global_load_lds((const unsigned*)(_g + (size_t)64 * (ld2) + _vo), (LAS unsigned*)(lds + (bufoff) + ldsw + 8192), 16, 0, 0); } while (0)
#define PG8_LDA(dst, b, h) do { _Pragma("unroll") for (int m = 0; m < 4; ++m) _Pragma("unroll") for (int k = 0; k < 2; ++k) dst[m][k] = *(const LAS bf16x8*)(lds + PG8_SA(b, h) + aoff + m * 2048 + k * 1024); } while (0)
#define PG8_LDB(dst, b, h) do { _Pragma("unroll") for (int n = 0; n < 2; ++n) _Pragma("unroll") for (int k = 0; k < 2; ++k) dst[n][k] = *(const LAS bf16x8*)(lds + PG8_SB(b, h) + boff + n * 2048 + k * 1024); } while (0)
#define PG8_MMA(ai, bj, At, Bt) do { __builtin_amdgcn_s_setprio(1); _Pragma("unroll") for (int m = 0; m < 4; ++m) _Pragma("unroll") for (int n = 0; n < 2; ++n) _Pragma("unroll") for (int k = 0; k < 2; ++k) \
        acc[ai][bj][m][n] = __builtin_amdgcn_mfma_f32_16x16x32_bf16(Bt[n][k], At[m][k], acc[ai][bj][m][n], 0, 0, 0); __builtin_amdgcn_s_setprio(0); } while (0)
#define PG8_WAIT_V(n) asm volatile("s_waitcnt vmcnt(" #n ")" ::: "memory")
#define PG8_WAIT_L(n) asm volatile("s_waitcnt lgkmcnt(" #n ")" ::: "memory")
#define PG8_BAR __builtin_amdgcn_s_barrier()
#define PG8_SCHED __builtin_amdgcn_sched_barrier(0)
    Unit cur, nxt; int ui = 0;
    if (!deal_next<NP>(S, 0, cur)) return;
    f32x4 acc[2][2][4][2];
#pragma unroll
    for (int a = 0; a < 2; ++a)
#pragma unroll
        for (int b = 0; b < 2; ++b)
#pragma unroll
            for (int m = 0; m < 4; ++m)
#pragma unroll
                for (int n = 0; n < 2; ++n) acc[a][b][m][n] = (f32x4){0.f, 0.f, 0.f, 0.f};
    bf16x8 At[4][2], B0[2][2], B1[2][2];
    float pre[8] = {0.f, 0.f, 0.f, 0.f, 0.f, 0.f, 0.f, 0.f};
    const size_t kstep = (size_t)(BK * 2);
    {
        const char* cA = cur.A; const char* cB = cur.B; const size_t hA = (size_t)HALF * cur.lda2, hB = (size_t)HALF * cur.ldb2;
        PG8_STAGE(PG8_SB(0, 0), cB, cur.ldb2); PG8_STAGE(PG8_SB(0, 1), cB + hB, cur.ldb2); PG8_STAGE(PG8_SA(0, 0), cA, cur.lda2); PG8_STAGE(PG8_SA(0, 1), cA + hA, cur.lda2);
        if (wr == 1) PG8_BAR;
        PG8_WAIT_V(2); PG8_BAR;
        PG8_STAGE(PG8_SB(1, 0), cB + kstep, cur.ldb2); PG8_STAGE(PG8_SA(1, 0), cA + kstep, cur.lda2); PG8_STAGE(PG8_SB(1, 1), cB + hB + kstep, cur.ldb2);
        PG8_WAIT_V(6); PG8_BAR;
    }
    for (;;) {
        const bool has_next = deal_next<NP>(S, ui + 1, nxt);
        if (!has_next) nxt = cur;
        const char* cA = cur.A; const char* cB = cur.B; const int lda2 = cur.lda2, ldb2 = cur.ldb2, nt = cur.nt;
        const size_t hA = (size_t)HALF * lda2;
        for (int t = 0; t < nt; t += 2) {
            const bool last = (t == nt - 2);
            const char* a1 = cA + (size_t)(t + 1) * kstep;
            const char* a2 = last ? nxt.A : cA + (size_t)(t + 2) * kstep; const char* b2 = last ? nxt.B : cB + (size_t)(t + 2) * kstep;
            const int la = last ? nxt.lda2 : lda2, lb = last ? nxt.ldb2 : ldb2;
            const size_t hA2 = (size_t)HALF * la, hB2 = (size_t)HALF * lb;
            const char* a3 = a2 + kstep; const char* b3 = b2 + kstep;
            E.kstep(acc, pre, t, cur.pm, wr, fr);
            if (last) E.prefetch(pre, cur.p, cur.pm, cur.pn, wr, fr);
            PG8_LDB(B0, 0, 0); PG8_LDB(B1, 0, 1); PG8_SCHED; PG8_LDA(At, 0, 0); PG8_STAGE(PG8_SA(1, 1), a1 + hA, lda2);
            PG8_WAIT_V(8); PG8_WAIT_L(0); PG8_BAR; PG8_MMA(0, 0, At, B0); PG8_MMA(0, 1, At, B1); PG8_BAR; PG8_SCHED;
            PG8_LDA(At, 0, 1); PG8_STAGE(PG8_SB(0, 0), b2, lb); PG8_STAGE(PG8_SB(0, 1), b2 + hB2, lb); PG8_STAGE(PG8_SA(0, 0), a2, la);
            PG8_WAIT_V(8); PG8_WAIT_L(0); PG8_BAR; PG8_MMA(1, 0, At, B0); PG8_MMA(1, 1, At, B1); PG8_BAR; PG8_SCHED;
            PG8_LDB(B0, 1, 0); PG8_LDB(B1, 1, 1); PG8_SCHED; PG8_LDA(At, 1, 0); PG8_STAGE(PG8_SA(0, 1), a2 + hA2, la);
            PG8_WAIT_V(8); PG8_WAIT_L(0); PG8_BAR; PG8_MMA(0, 0, At, B0); PG8_MMA(0, 1, At, B1); PG8_BAR; PG8_SCHED;
            PG8_LDA(At, 1, 1); PG8_STAGE(PG8_SB(1, 0), b3, lb); PG8_STAGE(PG8_SB(1, 1), b3 + hB2, lb); PG8_STAGE(PG8_SA(1, 0), a3, la);
            PG8_WAIT_V(8); PG8_WAIT_L(0); PG8_BAR; PG8_MMA(1, 0, At, B0); PG8_MMA(1, 1, At, B1); PG8_BAR; PG8_SCHED;
        }
        if (wr == 0) PG8_BAR;
        E(acc, pre, cur.p, cur.pm, cur.pn, wr, wc, fr, fq);
        if (!has_next) break;
#pragma unroll
        for (int a = 0; a < 2; ++a)
#pragma unroll
            for (int b = 0; b < 2; ++b)
#pragma unroll
                for (int m = 0; m < 4; ++m)
#pragma unroll
                    for (int n = 0; n < 2; ++n) acc[a][b][m][n] = (f32x4){0.f, 0.f, 0.f, 0.f};
        cur = nxt; ++ui;
        if (wr == 1) PG8_BAR;
    }
    PG8_WAIT_V(0);
    PG8_BAR;
#undef PG8_SA
#undef PG8_SB
#undef PG8_STAGE
#undef PG8_LDA
#undef PG8_LDB
#undef PG8_MMA
#undef PG8_WAIT_V
#undef PG8_WAIT_L
#undef PG8_BAR
#undef PG8_SCHED
}
}
typedef f32x4 Acc[2][2][4][2];

#define EPI_ARGS const Acc& acc, const float (&pre)[8], int p, int pm, int pn, int wr, int wc, int fr, int fq
#define EPI_NOKSTEP __device__ __forceinline__ void kstep(Acc&, float (&)[8], int, int, int, int) const {}
#define EPI_NOPRE EPI_NOKSTEP __device__ __forceinline__ void prefetch(float (&)[8], int, int, int, int, int) const {}
template <bool BF>
struct EpiF32S {
    static constexpr bool AFTER_DRAIN = false;
    EPI_NOPRE
    void* C; float* ssq;
    __device__ __forceinline__ void operator()(EPI_ARGS) const {
        const int row0 = pm * 256 + wr * 64 + fr, col0 = pn * 256 + wc * 32 + 8 * fq;
#pragma unroll
        for (int ai = 0; ai < 2; ++ai)
#pragma unroll
            for (int m = 0; m < 4; ++m) {
                const int row = row0 + ai * 128 + m * 16; float s = 0.f;
#pragma unroll
                for (int bj = 0; bj < 2; ++bj) {
                    const f32x4 v0 = acc[ai][bj][m][0], v1 = acc[ai][bj][m][1]; s += dot4(v0) + dot4(v1);
                    if (BF) { u32x4 w; w.x = cvt_pk_bf16(v0[0], v0[1]); w.y = cvt_pk_bf16(v0[2], v0[3]); w.z = cvt_pk_bf16(v1[0], v1[1]); w.w = cvt_pk_bf16(v1[2], v1[3]);
                        *(u32x4*)((bf16_t*)C + (size_t)row * DM + col0 + bj * 128) = w; }
                    else { float* rp = (float*)C + (size_t)row * DM + col0 + bj * 128; *(f32x4*)rp = v0; *(f32x4*)(rp + 4) = v1; }
                }
                if (ssq) { s += __shfl_xor(s, 16); s += __shfl_xor(s, 32); if (fq == 0) ssq[(size_t)row * 64 + pn * 4 + wc] = s; }
            }
    }
};
struct EpiOut {
    static constexpr bool AFTER_DRAIN = false;
    bf16_t* C; const float* RT;
    __device__ __forceinline__ void prefetch(float (&pr)[8], int, int pm, int, int wr, int fr) const {
#pragma unroll
        for (int g = 0; g < 8; ++g) pr[g] = RT[(size_t)(pm * 256 + wr * 64 + fr + (g >> 2) * 128 + (g & 3) * 16) * 4 + 2];
    }
    __device__ __forceinline__ void kstep(Acc& acc, float (&)[8], int t, int pm, int wr, int fr) const {
        if (t == 24 || t == 40) {
            int rb = (pm * 256 + wr * 64 + fr) * 4 + (t == 24 ? 0 : 1); asm volatile("" : "+v"(rb));
            float q[8];
#pragma unroll
            for (int g = 0; g < 8; ++g) q[g] = RT[rb + ((g >> 2) * 128 + (g & 3) * 16) * 4];
#pragma unroll
            for (int ai = 0; ai < 2; ++ai)
#pragma unroll
                for (int m = 0; m < 4; ++m)
#pragma unroll
                    for (int bj = 0; bj < 2; ++bj)
#pragma unroll
                        for (int n = 0; n < 2; ++n) acc[ai][bj][m][n] *= q[ai * 4 + m];
        }
    }
    __device__ __forceinline__ void operator()(EPI_ARGS) const {
        const int row0 = pm * 256 + wr * 64 + fr, col0 = pn * 256 + wc * 32 + 8 * fq;
#pragma unroll
        for (int ai = 0; ai < 2; ++ai)
#pragma unroll
            for (int m = 0; m < 4; ++m) {
                const int row = row0 + ai * 128 + m * 16; const float q = pre[ai * 4 + m];
#pragma unroll
                for (int bj = 0; bj < 2; ++bj) {
                    const f32x4 v0 = acc[ai][bj][m][0] * q, v1 = acc[ai][bj][m][1] * q;
                    u32x4 w; w.x = cvt_pk_bf16(v0[0], v0[1]); w.y = cvt_pk_bf16(v0[2], v0[3]); w.z = cvt_pk_bf16(v1[0], v1[1]); w.w = cvt_pk_bf16(v1[2], v1[3]);
                    *(u32x4*)(C + (size_t)row * DM + col0 + bj * 128) = w;
                }
            }
    }
};
__device__ __forceinline__ void ratio_rows(int tid, int pm, const float* GSS, float* RT) {
    if (tid < 256) {
        const int row = pm * 256 + tid; const f32x4* g = (const f32x4*)(GSS + (size_t)row * 40);
        f32x4 v[10];
#pragma unroll
        for (int j = 0; j < 10; ++j) v[j] = g[j];
        const f32x4 a4 = v[0] + v[1] + v[2], b4 = (v[3] + v[4]) + (v[5] + v[6]), c4 = v[7] + v[8] + v[9];
        const float sa = (a4.x + a4.y) + (a4.z + a4.w), sb = (b4.x + b4.y) + (b4.z + b4.w), sc = (c4.x + c4.y) + (c4.z + c4.w);
        const float ia = sqrtf(sa * (1.0f / 1536) + EPS), ib = sqrtf(sb * (1.0f / 1024) + EPS), ic = sqrtf(sc * (1.0f / 1536) + EPS);
        *(f32x4*)(RT + (size_t)row * 4) = (f32x4){ib / ia, ic / ib, 1.0f / ic, 0.f};
    }
}
struct EpiGU {
    static constexpr bool AFTER_DRAIN = false;
    bf16_t* ACT; const float* rstd;
    EPI_NOKSTEP
    __device__ __forceinline__ void prefetch(float (&pr)[8], int, int pm, int, int wr, int fr) const {
#pragma unroll
        for (int g = 0; g < 8; ++g) pr[g] = rstd[pm * 256 + wr * 64 + fr + (g >> 2) * 128 + (g & 3) * 16]; }
    __device__ __forceinline__ void operator()(EPI_ARGS) const {
        const int row0 = pm * 256 + wr * 64 + fr, f0 = pn * 128 + wc * 32 + 8 * fq;
#pragma unroll
        for (int ai = 0; ai < 2; ++ai)
#pragma unroll
            for (int m = 0; m < 4; ++m) {
                const int row = row0 + ai * 128 + m * 16; const float rs = pre[ai * 4 + m]; float a[2][4];
#pragma unroll
                for (int bj = 0; bj < 2; ++bj) {
                    const f32x4 g = acc[ai][bj][m][0] * rs, u = acc[ai][bj][m][1] * rs;
#pragma unroll
                    for (int j = 0; j < 4; ++j) a[bj][j] = g[j] * sigmoidf_(g[j]) * u[j];
                }
                u32x4 w; w.x = cvt_pk_bf16(a[0][0], a[0][1]); w.y = cvt_pk_bf16(a[0][2], a[0][3]); w.z = cvt_pk_bf16(a[1][0], a[1][1]); w.w = cvt_pk_bf16(a[1][2], a[1][3]);
                *(u32x4*)(ACT + (size_t)row * DFF + f0) = w;
            }
    }
};
template <bool LAST>
struct EpiPG {
    static constexpr bool AFTER_DRAIN = false;
    EPI_NOKSTEP
    __device__ __forceinline__ void prefetch(float (&pr)[8], int, int pm, int, int wr, int fr) const {
#pragma unroll
        for (int g = 0; g < 8; ++g) pr[g] = esc[pm * 256 + wr * 64 + fr + (g >> 2) * 128 + (g & 3) * 16]; }
    const bf16_t* X2; float* OUT; bf16_t* X3; const bf16_t* ERAW; const float* esc; const float* pg; const float* bias; float* ssq;
    __device__ __forceinline__ void operator()(EPI_ARGS) const {
        const int row0 = pm * 256 + wr * 64 + fr, col0 = pn * 256 + wc * 32 + 8 * fq;
        f32x4 bv[2][2], gv[2][2];
#pragma unroll
        for (int bj = 0; bj < 2; ++bj)
#pragma unroll
            for (int n = 0; n < 2; ++n) { bv[bj][n] = *(const f32x4*)(bias + col0 + bj * 128 + n * 4); gv[bj][n] = *(const f32x4*)(pg + col0 + bj * 128 + n * 4); }
        u32x4 xb[2][2], eb[2][2]; float es[2];
#define PG_LOAD(g, buf) do { const size_t off_ = (size_t)(row0 + ((g) >> 2) * 128 + ((g) & 3) * 16) * DM + col0; es[buf] = pre[g]; \
        _Pragma("unroll") for (int bj = 0; bj < 2; ++bj) { xb[buf][bj] = *(const u32x4*)(X2 + off_ + bj * 128); eb[buf][bj] = *(const u32x4*)(ERAW + off_ + bj * 128); } } while (0)
        PG_LOAD(0, 0);
#pragma unroll
        for (int g = 0; g < 8; ++g) {
            const int ai = g >> 2, m = g & 3, buf = g & 1;
            if (g + 1 < 8) PG_LOAD(g + 1, buf ^ 1);
            asm volatile("" ::: "memory");
            const int row = row0 + ai * 128 + m * 16; const size_t off = (size_t)row * DM + col0; float s = 0.f;
#pragma unroll
            for (int bj = 0; bj < 2; ++bj) {
                f32x4 o[2];
#pragma unroll
                for (int n = 0; n < 2; ++n) {
                    const f32x4 a = acc[ai][bj][m][n] + bv[bj][n];
                    const unsigned xw0 = n ? xb[buf][bj].z : xb[buf][bj].x, xw1 = n ? xb[buf][bj].w : xb[buf][bj].y, ew0 = n ? eb[buf][bj].z : eb[buf][bj].x, ew1 = n ? eb[buf][bj].w : eb[buf][bj].y;
                    const f32x4 x2 = {bflo(xw0), bfhi(xw0), bflo(xw1), bfhi(xw1)}, e = {bflo(ew0), bfhi(ew0), bflo(ew1), bfhi(ew1)};
#pragma unroll
                    for (int j = 0; j < 4; ++j) o[n][j] = x2[j] + sigmoidf_(a[j]) * (e[j] * es[buf] * gv[bj][n][j]);
                }
                if (LAST) { float* rp = OUT + off + bj * 128; *(f32x4*)rp = o[0]; *(f32x4*)(rp + 4) = o[1]; }
                else { s += dot4(o[0]) + dot4(o[1]); u32x4 w; w.x = cvt_pk_bf16(o[0][0], o[0][1]); w.y = cvt_pk_bf16(o[0][2], o[0][3]); w.z = cvt_pk_bf16(o[1][0], o[1][1]); w.w = cvt_pk_bf16(o[1][2], o[1][3]);
                    *(u32x4*)(X3 + off + bj * 128) = w; }
            }
            if (!LAST) { s += __shfl_xor(s, 16); s += __shfl_xor(s, 32); if (fq == 0) ssq[(size_t)row * 64 + pn * 4 + wc] = s; }
            asm volatile("" ::: "memory");
        }
#undef PG_LOAD
    }
};
__device__ __forceinline__ void st_plain8(bf16_t* rp, const f32x4 v0, const f32x4 v1) {
    u32x4 w; w.x = cvt_pk_bf16(v0[0], v0[1]); w.y = cvt_pk_bf16(v0[2], v0[3]); w.z = cvt_pk_bf16(v1[0], v1[1]); w.w = cvt_pk_bf16(v1[2], v1[3]);
    *(u32x4*)rp = w;
}
__device__ __forceinline__ void st_rope8(bf16_t* rp, int half, const f32x4 x1a, const f32x4 x1b, const f32x4 x2a, const f32x4 x2b, const f32x4 ca, const f32x4 cb, const f32x4 sa, const f32x4 sb) {
    const f32x4 y1a = x1a * ca - x2a * sa, y1b = x1b * cb - x2b * sb, y2a = x2a * ca + x1a * sa, y2b = x2b * cb + x1b * sb;
    u32x4 w1, w2; w1.x = cvt_pk_bf16(y1a[0], y1a[1]); w1.y = cvt_pk_bf16(y1a[2], y1a[3]); w1.z = cvt_pk_bf16(y1b[0], y1b[1]); w1.w = cvt_pk_bf16(y1b[2], y1b[3]);
    w2.x = cvt_pk_bf16(y2a[0], y2a[1]); w2.y = cvt_pk_bf16(y2a[2], y2a[3]); w2.z = cvt_pk_bf16(y2b[0], y2b[1]); w2.w = cvt_pk_bf16(y2b[2], y2b[3]);
    *(u32x4*)rp = w1; *(u32x4*)(rp + half) = w2;
}
__device__ __forceinline__ void st_rope(bf16_t* rp, int half, const f32x4 x1, const f32x4 x2, const f32x4 c, const f32x4 s) {
    const f32x4 y1 = x1 * c - x2 * s, y2 = x2 * c + x1 * s;
    u32x2 w1, w2; w1.x = cvt_pk_bf16(y1[0], y1[1]); w1.y = cvt_pk_bf16(y1[2], y1[3]); w2.x = cvt_pk_bf16(y2[0], y2[1]); w2.y = cvt_pk_bf16(y2[2], y2[3]);
    *(u32x2*)rp = w1; *(u32x2*)(rp + half) = w2;
}
struct EpiZ {
    EPI_NOKSTEP
    __device__ __forceinline__ void prefetch(float (&pr)[8], int p, int pm, int, int wr, int fr) const { if (p < 2) {
#pragma unroll
        for (int g = 0; g < 8; ++g) pr[g] = rstd[pm * 256 + wr * 64 + fr + (g >> 2) * 128 + (g & 3) * 16]; } }
    bf16_t *QA, *KA, *VA, *XR, *GG, *CQ, *CKV; float* KRP; float* ssq24; const float *rstd, *cos128, *sin128; bf16_t* ERAW; float* essq;
    __device__ __forceinline__ void operator()(EPI_ARGS) const {
        const int row0 = pm * 256 + wr * 64 + fr;
        if (p == 2) {
            const int col0 = pn * 256 + wc * 32 + 8 * fq;
#pragma unroll
            for (int ai = 0; ai < 2; ++ai)
#pragma unroll
                for (int m = 0; m < 4; ++m) {
                    const int row = row0 + ai * 128 + m * 16; float s = 0.f;
#pragma unroll
                    for (int bj = 0; bj < 2; ++bj) { const f32x4 v0 = acc[ai][bj][m][0], v1 = acc[ai][bj][m][1]; s += dot4(v0) + dot4(v1);
                        st_plain8(ERAW + (size_t)row * DM + col0 + bj * 128, v0, v1); }
                    s += __shfl_xor(s, 16); s += __shfl_xor(s, 32);
                    if (fq == 0) essq[(size_t)row * 64 + pn * 4 + wc] = s;
                }
        } else if (p == 1) {
            if (wc < 2) {
                const int dl = 16 * wc + 4 * fq;
#pragma unroll
                for (int ai = 0; ai < 2; ++ai)
#pragma unroll
                    for (int m = 0; m < 4; ++m) {
                        const int row = row0 + ai * 128 + m * 16; const float rs = pre[ai * 4 + m]; float* kp = KRP + ((size_t)pn * M + row) * 64 + dl;
                        *(f32x4*)kp = acc[ai][0][m][0] * rs; *(f32x4*)(kp + 32) = acc[ai][0][m][1] * rs;
                    }
            }
        } else if (pn < 8) {
            const int dl = 32 * (wc & 1) + 8 * fq, hh = 2 * pn + (wc >> 1);
            f32x4 cb[2][2], sb[2][2]; float rsb[2];
#define RZ_LOAD(g, buf) do { const int row_ = row0 + ((g) >> 2) * 128 + ((g) & 3) * 16; rsb[buf] = pre[g]; const float* cp_ = cos128 + (size_t)row_ * 64 + dl; const float* sp_ = sin128 + (size_t)row_ * 64 + dl; \
        cb[buf][0] = *(const f32x4*)cp_; cb[buf][1] = *(const f32x4*)(cp_ + 4); sb[buf][0] = *(const f32x4*)sp_; sb[buf][1] = *(const f32x4*)(sp_ + 4); } while (0)
            RZ_LOAD(0, 0);
#pragma unroll
            for (int g = 0; g < 8; ++g) {
                const int ai = g >> 2, m = g & 3, buf = g & 1;
                if (g + 1 < 8) RZ_LOAD(g + 1, buf ^ 1);
                asm volatile("" ::: "memory");
                const int row = row0 + ai * 128 + m * 16; const float rs = rsb[buf];
                bf16_t* rp = (hh < 12) ? QA + (size_t)row * 1536 + hh * 128 + dl : KA + (size_t)row * 512 + (hh - 12) * 128 + dl;
                st_rope8(rp, 64, acc[ai][0][m][0] * rs, acc[ai][1][m][0] * rs, acc[ai][0][m][1] * rs, acc[ai][1][m][1] * rs, cb[buf][0], cb[buf][1], sb[buf][0], sb[buf][1]);
                asm volatile("" ::: "memory");
            }
#undef RZ_LOAD
        } else {
            bf16_t* base; int pitch, ct, ssq0 = -1; bool gelu = false;
            if (pn < 10) { base = VA; pitch = 512; ct = pn - 8; }
            else if (pn < 14) { base = XR; pitch = 1024; ct = pn - 10; }
            else if (pn < 18) { base = GG; pitch = 1024; ct = pn - 14; gelu = true; }
            else if (pn < 22) { base = CQ; pitch = 1024; ct = pn - 18; ssq0 = (pn - 18) * 4 + wc; }
            else { base = CKV; pitch = 512; ct = pn - 22; ssq0 = 16 + (pn - 22) * 4 + wc; }
            const int col0 = ct * 256 + wc * 32 + 8 * fq;
            float rsa[8];
#pragma unroll
            for (int g = 0; g < 8; ++g) rsa[g] = pre[g];
#pragma unroll
            for (int ai = 0; ai < 2; ++ai)
#pragma unroll
                for (int m = 0; m < 4; ++m) {
                    const int row = row0 + ai * 128 + m * 16; const float rs = rsa[ai * 4 + m]; float s = 0.f;
#pragma unroll
                    for (int bj = 0; bj < 2; ++bj) {
                        f32x4 v0 = acc[ai][bj][m][0] * rs, v1 = acc[ai][bj][m][1] * rs;
                        if (gelu) {
#pragma unroll
                            for (int j = 0; j < 4; ++j) { v0[j] = gelu_tanh(v0[j]); v1[j] = gelu_tanh(v1[j]); }
                        }
                        s += dot4(v0) + dot4(v1);
                        st_plain8(base + (size_t)row * pitch + col0 + bj * 128, v0, v1);
                    }
                    if (ssq0 >= 0) { s += __shfl_xor(s, 16); s += __shfl_xor(s, 32); if (fq == 0) ssq24[(size_t)row * 24 + ssq0] = s; }
                }
        }
    }
};
struct EpiUp {
    EPI_NOPRE
    bf16_t *QN, *QR, *KVM; const float *ssq24, *cos64, *sin64;
    __device__ __forceinline__ void operator()(EPI_ARGS) const {
        const int row0 = pm * 256 + wr * 64 + fr;
        {
            float rs[2][4];
#pragma unroll
            for (int ai = 0; ai < 2; ++ai)
#pragma unroll
                for (int m = 0; m < 4; ++m) {
                    const float* sp = ssq24 + (size_t)(row0 + ai * 128 + m * 16) * 24; float s;
                    if (p == 0) { const f32x4 a = *(const f32x4*)sp, b = *(const f32x4*)(sp + 4), c = *(const f32x4*)(sp + 8), d = *(const f32x4*)(sp + 12);
                        s = ((a.x + a.y) + (a.z + a.w)) + ((b.x + b.y) + (b.z + b.w)) + ((c.x + c.y) + (c.z + c.w)) + ((d.x + d.y) + (d.z + d.w)); s *= (1.0f / QRANK); }
                    else { const f32x4 a = *(const f32x4*)(sp + 16), b = *(const f32x4*)(sp + 20); s = ((a.x + a.y) + (a.z + a.w)) + ((b.x + b.y) + (b.z + b.w)); s *= (1.0f / KVRANK); }
                    rs[ai][m] = 1.0f / sqrtf(s + EPS);
                }
            if (p == 0 && pn >= 6) {
                const int dl = 8 * fq, head = (pn - 6) * 4 + wc;
#pragma unroll
                for (int ai = 0; ai < 2; ++ai)
#pragma unroll
                    for (int m = 0; m < 4; ++m) {
                        const int row = row0 + ai * 128 + m * 16; const float r = rs[ai][m];
                        const float* cp_ = cos64 + (size_t)row * 32 + dl; const float* sp_ = sin64 + (size_t)row * 32 + dl;
                        st_rope8(QR + (size_t)row * 768 + head * 64 + dl, 32, acc[ai][0][m][0] * r, acc[ai][1][m][0] * r, acc[ai][0][m][1] * r, acc[ai][1][m][1] * r,
                                 *(const f32x4*)cp_, *(const f32x4*)(cp_ + 4), *(const f32x4*)sp_, *(const f32x4*)(sp_ + 4));
                    }
            } else {
                bf16_t* base = (p == 0) ? QN : KVM; const int pitch = (p == 0) ? 1536 : NKVU; const int col0 = pn * 256 + wc * 32 + 8 * fq;
#pragma unroll
                for (int ai = 0; ai < 2; ++ai)
#pragma unroll
                    for (int m = 0; m < 4; ++m) {
                        const int row = row0 + ai * 128 + m * 16; const float r = rs[ai][m];
#pragma unroll
                        for (int bj = 0; bj < 2; ++bj) st_plain8(base + (size_t)row * pitch + col0 + bj * 128, acc[ai][bj][m][0] * r, acc[ai][bj][m][1] * r);
                    }
            }
        }
    }
};
struct EpiGate {
    EPI_NOPRE
    const float *ba, *bx, *lam; const bf16_t* XC; float *AA, *BB;
    __device__ __forceinline__ void operator()(EPI_ARGS) const {
        const int row0 = pm * 256 + wr * 64 + fr;
        u32x2 xw[2][8];
#pragma unroll
        for (int bj = 0; bj < 2; ++bj)
#pragma unroll
            for (int g = 0; g < 8; ++g) xw[bj][g] = *(const u32x2*)(XC + (size_t)(row0 + (g >> 2) * 128 + (g & 3) * 16) * RGW + pn * 128 + bj * 64 + wc * 16 + 4 * fq);
#pragma unroll
        for (int bj = 0; bj < 2; ++bj) {
            const int ch = pn * 128 + bj * 64 + wc * 16 + 4 * fq;
            const f32x4 vba = *(const f32x4*)(ba + ch), vbx = *(const f32x4*)(bx + ch), c8 = *(const f32x4*)(lam + ch);
#pragma unroll
            for (int g = 0; g < 8; ++g) {
                const int ai = g >> 2, m = g & 3;
                const int row = row0 + ai * 128 + m * 16; const size_t off = (size_t)row * RGW + ch;
                const float xc[4] = {bflo(xw[bj][g].x), bfhi(xw[bj][g].x), bflo(xw[bj][g].y), bfhi(xw[bj][g].y)};
                const f32x4 ga = acc[ai][bj][m][0] + vba, gx = acc[ai][bj][m][1] + vbx; f32x4 av, bv;
#pragma unroll
                for (int j = 0; j < 4; ++j) {
                    const float r = sigmoidf_(ga[j]), ii = sigmoidf_(gx[j]), la = c8[j] * r;
                    const float x2 = 2.0f * la, av_ = __builtin_amdgcn_exp2f(1.4426950408889634f * la);
                    const float poly = -x2 * (1.0f + x2 * (0.5f + x2 * (0.16666667f + x2 * (0.041666668f + x2 * 0.008333334f))));
                    const float em = x2 > -0.25f ? poly : 1.0f - av_ * av_;
                    av[j] = av_; bv[j] = __builtin_amdgcn_sqrtf(em) * ii * xc[j];
                }
                *(f32x4*)(AA + off) = av; *(f32x4*)(BB + off) = bv;
            }
        }
    }
};

struct EpiMid {
    static constexpr bool AFTER_DRAIN = false;
    EpiUp up; EpiGate gate;
    __device__ __forceinline__ void operator()(EPI_ARGS) const { if (p > 0) up(acc, pre, p - 1, pm, pn, wr, wc, fr, fq); else gate(acc, pre, p, pm, pn, wr, wc, fr, fq); }
    EPI_NOPRE
};

namespace att {
constexpr int SHM_V = 64 * 128 * 2, SHM_K = 64 * 128 * 2, SHM_KR = 64 * 64 * 2;
constexpr int OFF_V = 0, OFF_K = 2 * SHM_V, OFF_KR = OFF_K + 2 * SHM_K, OFF_WS = OFF_KR + 2 * SHM_KR, OFF_UW = OFF_WS + 8 * 64 * 4, OFF_QR = OFF_UW + 64, ATT_LDS = OFF_QR + 8 * 4096;
static_assert(ATT_LDS <= RING_BYTES, "attention LDS");
constexpr float THR = 8.f;
#define KSWZ(row, colB) ((row) * 256 + ((colB) ^ (((row) & 7) << 4)))
#define KRSWZ(row, colB) ((row) * 128 + ((colB) ^ (((row) & 7) << 4)))
#define SBAR() __builtin_amdgcn_sched_barrier(0)
__device__ __forceinline__ int v_st(int k, int c) { const int kk = (k & ~0xC) | ((k & 4) << 1) | ((k & 8) >> 1); return ((kk >> 3) * 4 + (c >> 5)) * 512 + ((kk & 7) * 32 + (c & 31)) * 2; }
__device__ __forceinline__ int v_rd_base(int lane) { return ((lane & 3) << 3) | (((lane >> 2) & 3) << 6) | (((lane >> 4) & 1) << 5) | (((lane >> 5) & 1) << 8); }
constexpr int v_rd_off(int d0, int ks, int half) { return d0 * 512 + ks * 4096 + half * 2048; }
__device__ __forceinline__ int crow(int r, int hi) { return (r & 3) + 8 * (r >> 2) + 4 * hi; }
__device__ __forceinline__ void mask_tile(f32x16& p0, f32x16& p1, int dq, unsigned W) {
    const float NEG = -__builtin_inff();
#pragma unroll
    for (int r = 0; r < 16; ++r) {
        const int c = (r & 3) + 8 * (r >> 2);
        if ((unsigned)(dq - c) >= W) p0[r] = NEG;
        if ((unsigned)(dq - c - 32) >= W) p1[r] = NEG;
    }
}
__device__ __forceinline__ void partialSM(f32x16& p0, f32x16& p1, float& m_reg, float& alpha, float scale, float c2) {
    float pmax = p0[0];
#pragma unroll
    for (int r = 1; r < 16; ++r) pmax = fmaxf(pmax, p0[r]);
#pragma unroll
    for (int r = 0; r < 16; ++r) pmax = fmaxf(pmax, p1[r]);
    { auto rr = __builtin_amdgcn_permlane32_swap(__float_as_uint(pmax), __float_as_uint(pmax), false, false);
      pmax = fmaxf(__uint_as_float(rr[0]), __uint_as_float(rr[1])); }
    float mn;
    if (__builtin_expect(__all((pmax - m_reg) * scale <= THR), 1)) { mn = m_reg; alpha = 1.f; }
    else { mn = fmaxf(m_reg, pmax); alpha = __builtin_amdgcn_exp2f((m_reg - mn) * c2); m_reg = mn; }
    const float mnL = -mn * c2;
#pragma unroll
    for (int r = 0; r < 16; ++r) p0[r] = __builtin_amdgcn_exp2f(fmaf(p0[r], c2, mnL));
#pragma unroll
    for (int r = 0; r < 16; ++r) p1[r] = __builtin_amdgcn_exp2f(fmaf(p1[r], c2, mnL));
}
__device__ __forceinline__ void finishSM(f32x16& p0, f32x16& p1, float alpha, float& l_reg, bf16x8& pa0, bf16x8& pa1, bf16x8& pa2, bf16x8& pa3) {
    float ps = 0;
#pragma unroll
    for (int r = 0; r < 16; ++r) ps += p0[r];
#pragma unroll
    for (int r = 0; r < 16; ++r) ps += p1[r];
    { auto rr = __builtin_amdgcn_permlane32_swap(__float_as_uint(ps), __float_as_uint(ps), false, false);
      ps = __uint_as_float(rr[0]) + __uint_as_float(rr[1]); }
    l_reg = l_reg * alpha + ps;
#define PK4(P, B_, OUT) do { unsigned a0 = cvt_pk_bf16(P[B_+0], P[B_+1]), a1 = cvt_pk_bf16(P[B_+2], P[B_+3]);                          \
        unsigned b0 = cvt_pk_bf16(P[B_+4], P[B_+5]), b1 = cvt_pk_bf16(P[B_+6], P[B_+7]);                                             \
        auto r0 = __builtin_amdgcn_permlane32_swap(a0, b0, false, false); auto r1 = __builtin_amdgcn_permlane32_swap(a1, b1, false, false); \
        u32x4 w = {r0[0], r1[0], r0[1], r1[1]}; OUT = __builtin_bit_cast(bf16x8, w); } while (0)
    PK4(p0, 0, pa0); PK4(p0, 8, pa1); PK4(p1, 0, pa2); PK4(p1, 8, pa3);
#undef PK4
}
template <int KB, bool MLA>
__device__ __forceinline__ void qkt(f32x16& p0, f32x16& p1, const LAS char* K_lds, const LAS char* KR_lds, int r32, int hi, const bf16x8* qr, const LAS char* qrl, bool act) {
    if (!act) { const float NEG = -__builtin_inff();
#pragma unroll
        for (int r = 0; r < 16; ++r) { p0[r] = NEG; p1[r] = NEG; } return; }
#pragma unroll
    for (int r = 0; r < 16; ++r) { p0[r] = 0.f; p1[r] = 0.f; }
    const LAS char* kb[4];
#pragma unroll
    for (int dd = 0; dd < 4; ++dd) kb[dd] = K_lds + KB * SHM_K + KSWZ(r32, (dd * 16 + hi * 8) * 2);
#pragma unroll
    for (int d0 = 0; d0 < 8; ++d0) { const LAS char* a = kb[d0 & 3] + (d0 >> 2) * 128;
        const bf16x8 b0 = *(const LAS bf16x8*)a;
        const bf16x8 b1 = *(const LAS bf16x8*)(a + 32 * 256);
        p0 = __builtin_amdgcn_mfma_f32_32x32x16_bf16(b0, qr[d0], p0, 0, 0, 0);
        p1 = __builtin_amdgcn_mfma_f32_32x32x16_bf16(b1, qr[d0], p1, 0, 0, 0); }
    if (MLA) {
#pragma unroll
        for (int d0 = 0; d0 < 4; ++d0) { const LAS char* a = KR_lds + KB * SHM_KR + KRSWZ(r32, (d0 * 16 + hi * 8) * 2);
            const bf16x8 b0 = *(const LAS bf16x8*)a;
            const bf16x8 b1 = *(const LAS bf16x8*)(a + 32 * 128);
            const bf16x8 qf = *(const LAS bf16x8*)(qrl + KRSWZ(r32, (d0 * 16 + hi * 8) * 2));
            p0 = __builtin_amdgcn_mfma_f32_32x32x16_bf16(b0, qf, p0, 0, 0, 0);
            p1 = __builtin_amdgcn_mfma_f32_32x32x16_bf16(b1, qf, p1, 0, 0, 0); }
    }
}
template <int VB>
__device__ __forceinline__ void pv_tile(f32x16* o, int vb0, bf16x8 pa0, bf16x8 pa1, bf16x8 pa2, bf16x8 pa3, bool act) {
    if (!act) return;
#define TRRD(dst, off) asm volatile("ds_read_b64_tr_b16 %0, %1 offset:%2" : "=&v"(dst) : "v"(vb0), "i"(off) : "memory")
#define PV_D0(d0) do { s16x4 l0, l1, l2, l3, h0, h1, h2, h3; constexpr int b_ = VB * SHM_V + v_rd_off(d0, 0, 0); \
        TRRD(l0, b_); TRRD(h0, b_ + 2048); TRRD(l1, b_ + 4096); TRRD(h1, b_ + 6144); TRRD(l2, b_ + 8192); TRRD(h2, b_ + 10240); TRRD(l3, b_ + 12288); TRRD(h3, b_ + 14336); \
        asm volatile("s_waitcnt lgkmcnt(0)" ::: "memory"); SBAR(); \
        o[d0] = __builtin_amdgcn_mfma_f32_32x32x16_bf16(pa0, (bf16x8){l0[0], l0[1], l0[2], l0[3], h0[0], h0[1], h0[2], h0[3]}, o[d0], 0, 0, 0);   \
        o[d0] = __builtin_amdgcn_mfma_f32_32x32x16_bf16(pa1, (bf16x8){l1[0], l1[1], l1[2], l1[3], h1[0], h1[1], h1[2], h1[3]}, o[d0], 0, 0, 0);   \
        o[d0] = __builtin_amdgcn_mfma_f32_32x32x16_bf16(pa2, (bf16x8){l2[0], l2[1], l2[2], l2[3], h2[0], h2[1], h2[2], h2[3]}, o[d0], 0, 0, 0);   \
        o[d0] = __builtin_amdgcn_mfma_f32_32x32x16_bf16(pa3, (bf16x8){l3[0], l3[1], l3[2], l3[3], h3[0], h3[1], h3[2], h3[3]}, o[d0], 0, 0, 0); } while (0)
    PV_D0(0); PV_D0(1); PV_D0(2); PV_D0(3);
#undef PV_D0
#undef TRRD
}
struct Tens { const bf16_t* Q; const bf16_t* QR; const bf16_t* K; const bf16_t* V; const bf16_t* KR; bf16_t* O; float* SS; int qp, qrp, kp, vp, op; };
template <bool MLA>
__device__ __forceinline__ void attn_unit(LAS char* L, int wv, unsigned lbase, const Tens& T, int q0, int W, float m0, float l0, float scale) {
    const int tid = otid(wv), wid = __builtin_amdgcn_readfirstlane(tid >> 6), lane = tid & 63, r32 = lane & 31, hi = lane >> 5;
    const float c2 = 1.4426950408889634f * scale;
    const int lowk = q0 - W + 1, j_lo = lowk > 0 ? lowk / 64 : 0, j_hi = q0 / 64 + 4, NT = j_hi - j_lo;
    const int qlo = q0 + wid * 32, qm = qlo + r32 - 4 * hi;
    LAS char* V_lds = L + OFF_V; LAS char* K_lds = L + OFF_K; LAS char* KR_lds = L + OFF_KR;
    LAS float* ws = (LAS float*)(L + OFF_WS) + wid * 64; LAS float* li_l = ws; LAS float* al_l = ws + 32;
    float m_reg = m0, l_reg = l0; f32x16 o[4];
#pragma unroll
    for (int d = 0; d < 4; ++d)
#pragma unroll
        for (int r = 0; r < 16; ++r) o[d][r] = 0.f;
    const int sr = tid >> 4, sc = (tid & 15) * 8, vst0 = v_st(sr, sc), vst1 = v_st(32 + sr, sc), kws = KSWZ(sr, sc * 2);
    const int krr = tid >> 3, krc = (tid & 7) * 8, krws = KRSWZ(krr, krc * 2);
    const int vb0 = (int)lbase + OFF_V + v_rd_base(lane);
    bf16x8 qr[8]; LAS char* qrl = L + OFF_QR + wid * 4096;
#pragma unroll
    for (int d0 = 0; d0 < 8; ++d0) qr[d0] = *(const bf16x8*)(T.Q + (size_t)(wid * 32 + r32) * T.qp + d0 * 16 + hi * 8);
    if (MLA) {
#pragma unroll
        for (int d0 = 0; d0 < 4; ++d0) *(LAS bf16x8*)(qrl + KRSWZ(r32, (d0 * 16 + hi * 8) * 2)) = *(const bf16x8*)(T.QR + (size_t)(wid * 32 + r32) * T.qrp + d0 * 16 + hi * 8);
    }
    bf16x8 st_k0, st_k1, st_v0, st_v1, st_kr;
#define SLOAD(k0) do { st_v0 = *(const bf16x8*)(T.V + (size_t)((k0) + sr) * T.vp + sc); st_v1 = *(const bf16x8*)(T.V + (size_t)((k0) + 32 + sr) * T.vp + sc); \
                       st_k0 = *(const bf16x8*)(T.K + (size_t)((k0) + sr) * T.kp + sc); st_k1 = *(const bf16x8*)(T.K + (size_t)((k0) + 32 + sr) * T.kp + sc); \
                       if (MLA) st_kr = *(const bf16x8*)(T.KR + (size_t)((k0) + krr) * 64 + krc); } while (0)
#define SWRITE(bf) do { *(LAS bf16x8*)(V_lds + (bf) * SHM_V + vst0) = st_v0; *(LAS bf16x8*)(V_lds + (bf) * SHM_V + vst1) = st_v1; \
                        *(LAS bf16x8*)(K_lds + (bf) * SHM_K + kws) = st_k0; *(LAS bf16x8*)(K_lds + (bf) * SHM_K + kws + 32 * 256) = st_k1; \
                        if (MLA) *(LAS bf16x8*)(KR_lds + (bf) * SHM_KR + krws) = st_kr; } while (0)
#define KBASE(t) ((j_lo + (t)) * 64)
#define ACT(t) (KBASE(t) <= qlo + 31 && KBASE(t) + 63 >= qlo - W + 1)
#define STEP(BUF, t) do { \
        if ((t) + 1 < NT) SLOAD(KBASE((t) + 1)); \
        SBAR(); const bool act_ = ACT(t); \
        qkt<BUF, MLA>(p0, p1, K_lds, KR_lds, r32, hi, qr, qrl, act_); \
        { const int kb_ = KBASE(t); if (act_ && (kb_ + 63 > qlo || kb_ <= qlo + 31 - W)) mask_tile(p0, p1, qm - kb_, (unsigned)W); } \
        partialSM(p0, p1, m_reg, alpha, scale, c2); \
        if (__any(alpha < 1.f)) { if (hi == 0) al_l[r32] = alpha; LDS_WAIT(); \
            _Pragma("unroll") for (int d_ = 0; d_ < 4; ++d_) _Pragma("unroll") for (int r = 0; r < 16; ++r) o[d_][r] *= al_l[crow(r, hi)]; } \
        finishSM(p0, p1, alpha, l_reg, pa0, pa1, pa2, pa3); SBAR(); \
        pv_tile<BUF>(o, vb0, pa0, pa1, pa2, pa3, act_); \
        if ((t) + 1 < NT) { VM_WAIT(); SWRITE((BUF) ^ 1); } \
        __syncthreads(); } while (0)
    f32x16 p0, p1; float alpha; bf16x8 pa0, pa1, pa2, pa3;
    SLOAD(KBASE(0)); VM_WAIT(); SWRITE(0); __syncthreads();
    for (int t = 0; t < NT; t += 2) {
        STEP(0, t);
        if (t + 1 < NT) STEP(1, t + 1);
    }
    if (hi == 0) li_l[r32] = l_reg;
    LDS_WAIT();
    bf16_t* Ow = T.O + (size_t)(wid * 32) * T.op;
    float sq[16];
#pragma unroll
    for (int r = 0; r < 16; ++r) { const int orow = crow(r, hi); const float rl = __builtin_amdgcn_rcpf(li_l[orow]); float s = 0.f;
#pragma unroll
        for (int d0 = 0; d0 < 4; ++d0) { const float v = o[d0][r] * rl; const float vn = __shfl_xor(v, 1); s += v * v;
            if ((r32 & 1) == 0) *(unsigned*)(Ow + (size_t)orow * T.op + d0 * 32 + r32) = cvt_pk_bf16(v, vn); }
        sq[r] = s; }
    rs_step<8>(sq, (lane & 16) != 0, 16); rs_step<4>(sq, (lane & 8) != 0, 8); rs_step<2>(sq, (lane & 4) != 0, 4); rs_step<1>(sq, (lane & 2) != 0, 2);
    { const float tot = sq[0] + __shfl_xor(sq[0], 1); if ((r32 & 1) == 0) T.SS[(size_t)(wid * 32 + crow(r32 >> 1, hi)) * 40] = tot; }
    __syncthreads();
#undef SLOAD
#undef SWRITE
#undef KBASE
#undef ACT
#undef STEP
}
}

struct Args { const void* in[NIN]; float* out; unsigned char* ws; int ph_lo, ph_hi; float inv128[64]; float inv64[32]; };
struct Frame {
    LAS unsigned char* lds; unsigned* ctl; unsigned char* ws;
    int tid, lane, wave, vcu, G, gw, NGW;
    __device__ __forceinline__ void relane() { tid = otid(wave); lane = tid & 63; wave = __builtin_amdgcn_readfirstlane(tid >> 6); gw = vcu * 8 + wave; ws = oweak(ws); }
};
enum { I_X = 0, I_P, I_POS, I_PREMIX, I_WIN, I_SINK, I_CONVW, I_CONVB, I_GAW, I_GAB, I_GXW, I_GXB, I_LAM, I_QNORM, I_WUQ, I_KVNORM, I_WUKV, I_GNORM, I_WOUT, I_POSTMIX, I_PREFFN,
       I_WGATE, I_WUP, I_WDOWN, I_POSTFFN, I_WPLE, I_PLENORM, I_WPG, I_BPG };

struct TJob { const float* s0; long sd; const float* gain; bf16_t* dst; int K, ld, kind, nb; };
__device__ __forceinline__ const float* tj_col(const TJob& J, int np) {
    const int pn = np >> 8, r = np & 255, bj = r >> 7, wc = (r >> 5) & 3, n = (r >> 4) & 1, fq = (r >> 2) & 3;
    const int p8 = bj * 128 + wc * 32 + fq * 8 + n * 4;
    switch (J.kind) {
        case 1: if (pn < 8) return J.s0 + (2 * pn + (wc >> 1)) * 128 + 32 * (wc & 1) + 8 * fq + 4 * bj + 64 * n;
                if (pn < 24) return J.s0 + pn * 256 + p8;
                return nullptr;
        case 6: return (bj == 0 && wc < 2) ? J.s0 + (size_t)(512 * pn) * J.ld + 6144 + 16 * wc + 4 * fq + 32 * n : nullptr;
        case 2: if (pn < 6) { const int Lc = pn * 256 + p8; return J.s0 + (Lc >> 7) * 192 + (Lc & 127); }
                return J.s0 + ((pn - 6) * 4 + wc) * 192 + 128 + 8 * fq + 4 * bj + 32 * n;
        case 3: return J.s0 + pn * 256 + p8;
        case 4: return J.s0 + (long)n * J.sd + pn * (128 * 128) + 64 * bj + 16 * wc + 4 * fq;
        case 5: return J.s0 + (long)n * J.sd + pn * 128 + wc * 32 + fq * 8 + bj * 4;
        default: return J.s0 + pn * 256 + p8;
    }
}
__device__ __forceinline__ void tr_item(const TJob& J, int kb, int nb, LAS unsigned* T, int lane) {
    const int n4 = lane & 15, kq = lane >> 4, k0 = kb * 64;
    const float* cp = tj_col(J, nb * 64 + n4 * 4);
    f32x4 v0[8], v1[8];
#pragma unroll
    for (int i = 0; i < 8; ++i) { const int k = k0 + 8 * i + 2 * kq;
        if (cp) { v0[i] = __builtin_nontemporal_load((const f32x4*)(cp + (size_t)k * J.ld)); v1[i] = __builtin_nontemporal_load((const f32x4*)(cp + (size_t)(k + 1) * J.ld)); } else { v0[i] = (f32x4){0.f, 0.f, 0.f, 0.f}; v1[i] = v0[i]; } }
    const float* gp = J.gain; if (gp && J.kind == 6) gp += 512 * ((nb * 64) >> 8);
#pragma unroll
    for (int i = 0; i < 8; ++i) { const int k = k0 + 8 * i + 2 * kq; float g0 = 1.f, g1 = 1.f; if (gp) { g0 = gp[k]; g1 = gp[k + 1]; }
#pragma unroll
        for (int jj = 0; jj < 4; ++jj) T[(n4 * 4 + jj) * 32 + ((i ^ (n4 & 7)) * 4 + kq)] = cvt_pk_bf16(v0[i][jj] * g0, v1[i][jj] * g1); }
    LDS_WAIT(); asm volatile("" ::: "memory");
#pragma unroll
    for (int ps = 0; ps < 8; ++ps) { const int row = ps * 8 + (lane >> 3), c = lane & 7;
        const u32x4 w = *(const LAS u32x4*)(T + row * 32 + ((c ^ ((row >> 2) & 7)) * 4));
        __builtin_nontemporal_store(w, (u32x4*)(J.dst + (size_t)(nb * 64 + row) * J.K + k0 + 8 * c)); }
    LDS_WAIT(); asm volatile("" ::: "memory");
}
constexpr int TI_Z = 64 * 96, TI_KR = 8 * 32, TI_UQ = 16 * 36, TI_UKV = 8 * 48, TI_RG = 2 * 32, TI_OUT = 64 * 64, TI_GU = 64 * 344, TI_DN = 172 * 64, TI_PLE = 4 * 64, TI_PG = 64 * 64;
constexpr int TI_LAYER = TI_Z + TI_KR + TI_UQ + TI_UKV + TI_RG + TI_OUT + TI_GU + TI_DN + TI_PLE + TI_PG;
constexpr int TI_EARLY = TI_Z + TI_KR + TI_UQ + TI_UKV + TI_RG + TI_PLE;
__device__ __forceinline__ void convert_items(const Frame& F, const Args& a, int it0, int it1, int gw = -1, int ngw = 0) {
    LAS unsigned* T = (LAS unsigned*)(F.lds + F.wave * 8192);
    if (gw < 0) { gw = F.gw; ngw = F.NGW; }
    for (int it = it0 + gw; it < it1; it += ngw) {
        const int l = it / TI_LAYER; int r = it % TI_LAYER;
        unsigned char* wl = F.ws + WS_W + (size_t)l * W_LAYER; TJob J; J.sd = 0; J.gain = nullptr;
        if (r < TI_Z) { J.s0 = (const float*)a.in[I_WIN] + (size_t)l * DM * NZ; J.gain = (const float*)a.in[I_PREMIX] + l * DM; J.dst = (bf16_t*)(wl + WO_Z); J.K = DM; J.ld = NZ; J.kind = 1; J.nb = 96; }
        else if ((r -= TI_Z) < TI_KR) { J.s0 = (const float*)a.in[I_WIN] + (size_t)l * DM * NZ; J.gain = (const float*)a.in[I_PREMIX] + l * DM; J.dst = (bf16_t*)(wl + WO_KR); J.K = 512; J.ld = NZ; J.kind = 6; J.nb = 32; }
        else if ((r -= TI_KR) < TI_UQ) { J.s0 = (const float*)a.in[I_WUQ] + (size_t)l * QRANK * NQU; J.gain = (const float*)a.in[I_QNORM] + l * QRANK; J.dst = (bf16_t*)(wl + WO_UQ); J.K = QRANK; J.ld = NQU; J.kind = 2; J.nb = 36; }
        else if ((r -= TI_UQ) < TI_UKV) { J.s0 = (const float*)a.in[I_WUKV] + (size_t)l * KVRANK * NKVU; J.gain = (const float*)a.in[I_KVNORM] + l * KVRANK; J.dst = (bf16_t*)(wl + WO_UKV); J.K = KVRANK; J.ld = NKVU; J.kind = 3; J.nb = 48; }
        else if ((r -= TI_UKV) < TI_RG) { J.s0 = (const float*)a.in[I_GAW] + (size_t)l * 8 * 128 * 128; J.sd = (const float*)a.in[I_GXW] - (const float*)a.in[I_GAW]; J.dst = (bf16_t*)(wl + WO_RG); J.K = 128; J.ld = 128; J.kind = 4; J.nb = 32; }
        else if ((r -= TI_RG) < TI_PLE) { J.s0 = (const float*)a.in[I_WPLE] + (size_t)l * PLE * DM; J.dst = (bf16_t*)(wl + WO_PLE); J.K = PLE; J.ld = DM; J.kind = 0; J.nb = 64; }
        else if ((r -= TI_PLE) < TI_OUT) { J.s0 = (const float*)a.in[I_WOUT] + (size_t)l * DM * DM; J.gain = (const float*)a.in[I_GNORM] + l * DM; J.dst = (bf16_t*)(wl + WO_OUT); J.K = DM; J.ld = DM; J.kind = 0; J.nb = 64; }
        else if ((r -= TI_OUT) < TI_GU) { J.s0 = (const float*)a.in[I_WGATE] + (size_t)l * DM * DFF; J.sd = (const float*)a.in[I_WUP] - (const float*)a.in[I_WGATE]; J.gain = (const float*)a.in[I_PREFFN] + l * DM; J.dst = (bf16_t*)(wl + WO_GU); J.K = DM; J.ld = DFF; J.kind = 5; J.nb = 344; }
        else if ((r -= TI_GU) < TI_DN) { J.s0 = (const float*)a.in[I_WDOWN] + (size_t)l * DFF * DM; J.dst = (bf16_t*)(wl + WO_DN); J.K = DFF; J.ld = DM; J.kind = 0; J.nb = 64; }
        else { r -= TI_DN; J.s0 = (const float*)a.in[I_WPG] + (size_t)l * DM * DM; J.dst = (bf16_t*)(wl + WO_PG); J.K = DM; J.ld = DM; J.kind = 0; J.nb = 64; }
        tr_item(J, r / J.nb, r % J.nb, T, F.lane);
    }
}
__device__ __forceinline__ void prologue(const Frame& F, const Args& a) {
    convert_items(F, a, 0, TI_EARLY);
    const int gt = F.vcu * 512 + F.tid, NGT = F.G * 512;
    const int* pos = (const int*)a.in[I_POS];
    float* c128 = (float*)(F.ws + WS_COS128); float* s128 = (float*)(F.ws + WS_SIN128); float* c64 = (float*)(F.ws + WS_COS64); float* s64 = (float*)(F.ws + WS_SIN64);
    for (int i0 = gt; i0 < M * 96; i0 += 6 * NGT) {
        int pr[6];
#pragma unroll
        for (int u = 0; u < 6; ++u) { const int i = i0 + u * NGT; pr[u] = i < M * 96 ? pos[i / 96] : 0; }
#pragma unroll
        for (int u = 0; u < 6; ++u) { const int i = i0 + u * NGT; if (i < M * 96) {
            const int row = i / 96, k = i % 96; const float inv = k < 64 ? a.inv128[k] : a.inv64[k - 64];
            const float ang = (float)pr[u] * inv; double rev = (double)ang * 0.15915494309189535; rev -= rint(rev); const float fr = (float)rev;
            const float c = __builtin_amdgcn_cosf(fr), s = __builtin_amdgcn_sinf(fr);
            if (k < 64) { c128[(size_t)row * 64 + k] = c; s128[(size_t)row * 64 + k] = s; } else { c64[(size_t)row * 32 + k - 64] = c; s64[(size_t)row * 32 + k - 64] = s; } } }
    }
    { const float* lam = (const float*)a.in[I_LAM]; float* c8 = (float*)(F.ws + WS_C8);
      for (int i = gt; i < DEPTH * RGW; i += NGT) c8[i] = -8.0f * log1pf(expf(-lam[i])); }
    { const f32x4* ps = (const f32x4*)a.in[I_P]; u32x2* pd = (u32x2*)(F.ws + WS_PB);
      for (int i0 = gt; i0 < DEPTH * M * PLE / 4; i0 += 8 * NGT) {
          f32x4 v[8];
#pragma unroll
          for (int u = 0; u < 8; ++u) { const int i = i0 + u * NGT; v[u] = i < DEPTH * M * PLE / 4 ? __builtin_nontemporal_load(ps + i) : (f32x4){0.f, 0.f, 0.f, 0.f}; }
#pragma unroll
          for (int u = 0; u < 8; ++u) { const int i = i0 + u * NGT; if (i < DEPTH * M * PLE / 4) { u32x2 w; w.x = cvt_pk_bf16(v[u].x, v[u].y); w.y = cvt_pk_bf16(v[u].z, v[u].w); pd[i] = w; } } } }
    { const float* x = (const float*)a.in[I_X]; bf16_t* XB = (bf16_t*)(F.ws + WS_XB); float* rstd = (float*)(F.ws + WS_RSTD);
      for (int m0 = F.gw; m0 < M; m0 += 2 * F.NGW) {
          const int m1 = m0 + F.NGW; const bool has1 = m1 < M;
          const f32x4* xr0 = (const f32x4*)(x + (size_t)m0 * DM) + F.lane; const f32x4* xr1 = (const f32x4*)(x + (size_t)(has1 ? m1 : m0) * DM) + F.lane;
          f32x4 v0[16], v1[16];
#pragma unroll
          for (int j = 0; j < 16; ++j) { v0[j] = __builtin_nontemporal_load(xr0 + 64 * j); v1[j] = __builtin_nontemporal_load(xr1 + 64 * j); }
#pragma unroll
          for (int rr = 0; rr < 2; ++rr) {
              if (rr == 1 && !has1) break;
              const int m = rr ? m1 : m0; u32x2* o = (u32x2*)(XB + (size_t)m * DM) + F.lane; float s = 0.f;
#pragma unroll
              for (int j = 0; j < 16; ++j) { const f32x4 v = rr ? v1[j] : v0[j]; s += dot4(v); u32x2 w; w.x = cvt_pk_bf16(v.x, v.y); w.y = cvt_pk_bf16(v.z, v.w); o[64 * j] = w; }
              s = wave_sum(s); if (F.lane == 0) rstd[m] = 1.0f / sqrtf(s * (1.0f / DM) + EPS);
          }
      } }
}
__device__ __forceinline__ void kr_finish(const Frame& F, const float* KRP, const float* c64, const float* s64, bf16_t* KR) {
    const int gt = F.vcu * 512 + F.tid, NGT = F.G * 512;
    for (int it = gt; it < M * 8; it += NGT) {
        const int row = it >> 3, d = (it & 7) * 4; f32x4 x1 = {0.f, 0.f, 0.f, 0.f}, x2 = x1;
#pragma unroll
        for (int sl = 0; sl < 8; ++sl) { const float* kp = KRP + ((size_t)sl * M + row) * 64 + d; x1 += *(const f32x4*)kp; x2 += *(const f32x4*)(kp + 32); }
        const f32x4 c = *(const f32x4*)(c64 + (size_t)row * 32 + d), sn = *(const f32x4*)(s64 + (size_t)row * 32 + d);
        st_rope(KR + (size_t)row * 64 + d, 32, x1, x2, c, sn);
    }
}
__device__ __forceinline__ void conv_tile(int tid, int pm, int blk, const bf16_t* XR, const float* cw, const float* cb, bf16_t* XC) {
    const int cg = blk * 128 + (tid & 15) * 8;
    const f32x4 b0 = *(const f32x4*)(cb + cg), b1 = *(const f32x4*)(cb + cg + 4);
    f32x4 w0[4], w1[4];
#pragma unroll
    for (int w = 0; w < 4; ++w) { w0[w] = *(const f32x4*)(cw + w * RGW + cg); w1[w] = *(const f32x4*)(cw + w * RGW + cg + 4); }
#pragma unroll
    for (int jh = 0; jh < 2; ++jh) {
        u32x4 xv[4][4];
#pragma unroll
        for (int jj = 0; jj < 4; ++jj) { const int row = pm * 256 + (jh * 4 + jj) * 32 + (tid >> 4), sq = row & (SEQ - 1);
#pragma unroll
            for (int w = 0; w < 4; ++w) xv[jj][w] = (sq - 3 + w >= 0) ? *(const u32x4*)(XR + (size_t)(row - 3 + w) * RGW + cg) : (u32x4){0u, 0u, 0u, 0u}; }
#pragma unroll
        for (int jj = 0; jj < 4; ++jj) { const int row = pm * 256 + (jh * 4 + jj) * 32 + (tid >> 4);
            f32x4 a0 = b0, a1 = b1;
#pragma unroll
            for (int w = 0; w < 4; ++w) {
                a0.x += w0[w].x * bflo(xv[jj][w].x); a0.y += w0[w].y * bfhi(xv[jj][w].x); a0.z += w0[w].z * bflo(xv[jj][w].y); a0.w += w0[w].w * bfhi(xv[jj][w].y);
                a1.x += w1[w].x * bflo(xv[jj][w].z); a1.y += w1[w].y * bfhi(xv[jj][w].z); a1.z += w1[w].z * bflo(xv[jj][w].w); a1.w += w1[w].w * bfhi(xv[jj][w].w);
            }
            u32x4 o; o.x = cvt_pk_bf16(a0.x, a0.y); o.y = cvt_pk_bf16(a0.z, a0.w); o.z = cvt_pk_bf16(a1.x, a1.y); o.w = cvt_pk_bf16(a1.z, a1.w);
            *(u32x4*)(XC + (size_t)row * RGW + cg) = o; }
    }
}
__device__ __forceinline__ void scan_pass1(const Frame& F, const float* AA, const float* BB, float* CP, float* CL) {
    const int gt = F.vcu * 512 + F.tid, NGT = F.G * 512;
    for (int it = gt; it < NB * 32 * RGW; it += NGT) {
        const int ch = it & (RGW - 1), ck = (it >> 10) & 31, b = it >> 15; const size_t base = (size_t)(b * SEQ + ck * 64) * RGW + ch;
        float P = 1.f, Lh = 0.f;
#pragma unroll
        for (int t0 = 0; t0 < 64; t0 += 32) {
            float av[32], bv[32];
#pragma unroll
            for (int t = 0; t < 32; ++t) { av[t] = AA[base + (size_t)(t0 + t) * RGW]; bv[t] = BB[base + (size_t)(t0 + t) * RGW]; }
#pragma unroll
            for (int t = 0; t < 32; ++t) { Lh = av[t] * Lh + bv[t]; P *= av[t]; }
        }
        CP[it] = P; CL[it] = Lh;
    }
}
__device__ __forceinline__ void scan_pass1_tile(int tid, int pm, int blk, const float* AA, const float* BB, float* CP, float* CL) {
    const int ch = blk * 128 + (tid & 127), row0 = pm * 256 + (tid >> 7) * 64, b = row0 >> 11, ck = (row0 & (SEQ - 1)) >> 6; const size_t base = (size_t)row0 * RGW + ch;
    float P = 1.f, Lh = 0.f;
#pragma unroll
    for (int t0 = 0; t0 < 64; t0 += 32) {
        float av[32], bv[32];
#pragma unroll
        for (int t = 0; t < 32; ++t) { av[t] = AA[base + (size_t)(t0 + t) * RGW]; bv[t] = BB[base + (size_t)(t0 + t) * RGW]; }
#pragma unroll
        for (int t = 0; t < 32; ++t) { Lh = av[t] * Lh + bv[t]; P *= av[t]; }
    }
    const int it = (b * 32 + ck) * RGW + ch; CP[it] = P; CL[it] = Lh;
}
__device__ __forceinline__ void scan_pass2(const Frame& F, const float* AA, const float* BB, const float* CP, const float* CL, const bf16_t* GG, bf16_t* OC, float* GSS) {
    const int gt = F.vcu * 512 + F.tid, NGT = F.G * 512;
    for (int it = gt; it < NB * 32 * RGW; it += NGT) {
        const int ch = it & (RGW - 1), ck = (it >> 10) & 31, b = it >> 15; const size_t row0 = (size_t)(b * SEQ + ck * 64);
        float h = 0.f;
        { float cp[32], cl[32];
#pragma unroll
          for (int cc = 0; cc < 32; ++cc) { const int j = (b * 32 + cc) * RGW + ch; cp[cc] = CP[j]; cl[cc] = CL[j]; }
#pragma unroll
          for (int cc = 0; cc < 32; ++cc) if (cc < ck) h = cp[cc] * h + cl[cc]; }
        for (int t0 = 0; t0 < 64; t0 += 32) {
            float av[32], bv[32]; unsigned short gv[32];
#pragma unroll
            for (int t = 0; t < 32; ++t) { const size_t r = row0 + t0 + t; av[t] = AA[r * RGW + ch]; bv[t] = BB[r * RGW + ch]; gv[t] = GG[r * RGW + ch]; }
#pragma unroll
            for (int t = 0; t < 32; ++t) { h = av[t] * h + bv[t]; const float ov = h * bf2f(gv[t]); OC[(row0 + t0 + t) * DM + 1536 + ch] = (bf16_t)(cvt_pk_bf16(ov, 0.f) & 0xffffu); av[t] = ov * ov; }
            rs_step<16>(av, (F.lane & 16) != 0, 16); rs_step<8>(av, (F.lane & 8) != 0, 8); rs_step<4>(av, (F.lane & 4) != 0, 4); rs_step<2>(av, (F.lane & 2) != 0, 2); rs_step<1>(av, (F.lane & 1) != 0, 1);
            { const float tot = av[0] + __shfl_xor(av[0], 32); if (F.lane < 32) GSS[(row0 + t0 + F.lane) * 40 + 12 + (ch >> 6)] = tot; }
        }
    }
}
__device__ __forceinline__ void groupnorm_phase(const Frame& F, const bf16_t* OC, bf16_t* MIX) {
    for (int m0 = F.gw; m0 < M; m0 += 2 * F.NGW) {
        const int m1 = m0 + F.NGW; const bool has1 = m1 < M;
        const u32x4* srcA = (const u32x4*)(OC + (size_t)m0 * DM) + F.lane; const u32x4* srcB = (const u32x4*)(OC + (size_t)(has1 ? m1 : m0) * DM) + F.lane;
        u32x4 va[8], vb[8];
#pragma unroll
        for (int j = 0; j < 8; ++j) { va[j] = srcA[64 * j]; vb[j] = srcB[64 * j]; }
#pragma unroll
        for (int rr = 0; rr < 2; ++rr) {
            if (rr == 1 && !has1) break;
            float s[8];
#pragma unroll
            for (int j = 0; j < 8; ++j) { const u32x4 v = rr ? vb[j] : va[j]; float t = 0.f;
#pragma unroll
                for (int e = 0; e < 4; ++e) { const float lo = bflo(v[e]), hi = bfhi(v[e]); t += lo * lo + hi * hi; }
                s[j] = t; }
            const float sa = wave_sum(s[0] + s[1] + s[2]), sb = wave_sum(s[3] + s[4]), sc = wave_sum(s[5] + s[6] + s[7]);
            const float ra = 1.0f / sqrtf(sa * (1.0f / 1536) + EPS), rb = 1.0f / sqrtf(sb * (1.0f / 1024) + EPS), rc = 1.0f / sqrtf(sc * (1.0f / 1536) + EPS);
            u32x4* dst = (u32x4*)(MIX + (size_t)(rr ? m1 : m0) * DM) + F.lane;
#pragma unroll
            for (int j = 0; j < 8; ++j) { const u32x4 v = rr ? vb[j] : va[j]; const float r = j < 3 ? ra : (j < 5 ? rb : rc); u32x4 w;
#pragma unroll
                for (int e = 0; e < 4; ++e) w[e] = cvt_pk_bf16(bflo(v[e]) * r, bfhi(v[e]) * r);
                dst[64 * j] = w; }
        }
    }
}
template <bool XF>
__device__ __forceinline__ void residual_phase(const Frame& F, const void* xin, const bf16_t* Y, const float* g, bf16_t* XO, float* rstd_out, const float* essq, float* esc) {
    for (int m = F.gw; m < M; m += F.NGW) {
        const u32x4* yr = (const u32x4*)(Y + (size_t)m * DM) + F.lane; const f32x4* gr = (const f32x4*)g + 2 * F.lane;
        u32x4 yv[8]; f32x4 xa[8][2]; float s = 0.f;
#pragma unroll
        for (int j = 0; j < 8; ++j) yv[j] = yr[64 * j];
        if (XF) { const f32x4* xr = (const f32x4*)((const float*)xin + (size_t)m * DM) + 2 * F.lane;
#pragma unroll
            for (int j = 0; j < 8; ++j) { xa[j][0] = xr[128 * j]; xa[j][1] = xr[128 * j + 1]; } }
        else { const u32x4* xr = (const u32x4*)((const bf16_t*)xin + (size_t)m * DM) + F.lane;
#pragma unroll
            for (int j = 0; j < 8; ++j) { const u32x4 w = xr[64 * j]; xa[j][0] = (f32x4){bflo(w.x), bfhi(w.x), bflo(w.y), bfhi(w.y)}; xa[j][1] = (f32x4){bflo(w.z), bfhi(w.z), bflo(w.w), bfhi(w.w)}; } }
#pragma unroll
        for (int j = 0; j < 8; ++j)
#pragma unroll
            for (int e = 0; e < 4; ++e) { const float lo = bflo(yv[j][e]), hi = bfhi(yv[j][e]); s += lo * lo + hi * hi; }
        const float ry = 1.0f / sqrtf(wave_sum(s) * (1.0f / DM) + EPS); float s1 = 0.f;
        u32x4* xo = (u32x4*)(XO + (size_t)m * DM) + F.lane;
#pragma unroll
        for (int j = 0; j < 8; ++j) {
            const f32x4 g0 = gr[128 * j], g1 = gr[128 * j + 1];
            const f32x4 y0 = {bflo(yv[j].x), bfhi(yv[j].x), bflo(yv[j].y), bfhi(yv[j].y)}, y1 = {bflo(yv[j].z), bfhi(yv[j].z), bflo(yv[j].w), bfhi(yv[j].w)};
            const f32x4 o0 = xa[j][0] + y0 * ry * g0, o1 = xa[j][1] + y1 * ry * g1;
            s1 += dot4(o0) + dot4(o1);
            u32x4 w; w.x = cvt_pk_bf16(o0[0], o0[1]); w.y = cvt_pk_bf16(o0[2], o0[3]); w.z = cvt_pk_bf16(o1[0], o1[1]); w.w = cvt_pk_bf16(o1[2], o1[3]);
            xo[64 * j] = w;
        }
        if (rstd_out) { const float t = wave_sum(s1); if (F.lane == 0) rstd_out[m] = 1.0f / sqrtf(t * (1.0f / DM) + EPS); }
        if (esc) { const float e = wave_sum(essq[(size_t)m * 64 + F.lane]); if (F.lane == 0) esc[m] = 1.0f / sqrtf(e * (1.0f / DM) + EPS); }
    }
}
__device__ __forceinline__ void rstd_phase(const Frame& F, const float* ssq64, float* rstd) {
    for (int m = F.gw; m < M; m += F.NGW) { const float e = wave_sum(ssq64[(size_t)m * 64 + F.lane]); if (F.lane == 0) rstd[m] = 1.0f / sqrtf(e * (1.0f / DM) + EPS); }
}

template <bool MLA, class F2>
__device__ __forceinline__ void attn_phase(const Frame& F, unsigned* qhead, int nunits, const F2& run_unit) {
    LAS char* L = (LAS char*)F.lds; volatile LAS unsigned* uw = (volatile LAS unsigned*)(L + att::OFF_UW);
    for (;;) {
        if (F.tid == 0) *uw = __hip_atomic_fetch_add(qhead, 1u, __ATOMIC_RELAXED, __HIP_MEMORY_SCOPE_AGENT);
        __syncthreads(); const unsigned u = *uw; __syncthreads();
        if (u >= (unsigned)nunits) break;
        run_unit((int)u, L);
    }
}

constexpr int CV_G1_0 = TI_EARLY, CV_G1_1 = TI_EARLY + TI_OUT;
constexpr int CV_AT_0 = CV_G1_1, CV_AT_1 = CV_AT_0 + TI_GU + TI_DN;
constexpr int CV_G3_0 = CV_AT_1, CV_G3_1 = CV_AT_1;
constexpr int CV_G4_0 = CV_G3_1, CV_G4_1 = 2 * TI_LAYER;
static_assert(CV_G4_0 == TI_LAYER - TI_PG, "job order");
constexpr int NPH = 13, N_PHASES = 1 + DEPTH * NPH - 1;

#define P_QA ((bf16_t*)(ws + WS_R1 + R1_QA))
#define P_KA ((bf16_t*)(ws + WS_R1 + R1_KA))
#define P_VA ((bf16_t*)(ws + WS_R1 + R1_VA))
#define P_XR ((bf16_t*)(ws + WS_R1 + R1_XR))
#define P_GG ((bf16_t*)(ws + WS_R1 + R1_GG))
#define P_CQ ((bf16_t*)(ws + WS_R1 + R1_CQ))
#define P_CKV ((bf16_t*)(ws + WS_R1 + R1_CKV))
#define P_KR ((bf16_t*)(ws + WS_R1 + R1_KR))
#define P_QN ((bf16_t*)(ws + WS_R1 + R1_QN))
#define P_QR ((bf16_t*)(ws + WS_R1 + R1_QR))
#define P_XC ((bf16_t*)(ws + WS_R1 + R1_XC))
#define P_ACT ((bf16_t*)(ws + WS_R1))
#define P_KVM ((bf16_t*)(ws + WS_R2 + R2_KVM))
#define P_KRP ((float*)(ws + WS_R2 + R2_END))
#define P_AA ((float*)(ws + WS_R2 + R2_AA))
#define P_BB ((float*)(ws + WS_R2 + R2_BB))
#define P_MO ((bf16_t*)(ws + WS_R2))
#define P_X1 ((bf16_t*)(ws + WS_OC))
#define P_X3 ((bf16_t*)(ws + WS_ERAW + (size_t)M * DM * 2))
#define P_OC ((bf16_t*)(ws + WS_OC))
#define P_MIX ((bf16_t*)(ws + WS_MIX))
#define P_GSS ((float*)(ws + WS_GSS))
#define P_RT ((float*)(ws + WS_RT))
#define P_XB ((bf16_t*)(ws + WS_XB))
#define P_ERAW ((bf16_t*)(ws + WS_ERAW))
#define P_SSQ24 ((float*)(ws + WS_SSQ24))
#define P_SSQ64 ((float*)(ws + WS_SSQ64))
#define P_ESSQ ((float*)(ws + WS_ESSQ))
#define P_RSTD ((float*)(ws + WS_RSTD))
#define P_ESC ((float*)(ws + WS_ESC))
#define P_CP ((float*)(ws + WS_CP))
#define P_CL ((float*)(ws + WS_CL))
#define P_C128 ((const float*)(ws + WS_COS128))
#define P_S128 ((const float*)(ws + WS_SIN128))
#define P_C64 ((const float*)(ws + WS_COS64))
#define P_S64 ((const float*)(ws + WS_SIN64))
#define P_WL(off) ((const bf16_t*)(ws + WS_W + (size_t)l * W_LAYER + (off)))

__global__ void __launch_bounds__(512, 2) fwd(Args a) {
    extern __shared__ __attribute__((aligned(16))) unsigned char lds_raw[];
    Frame F;
    F.lds = (LAS unsigned char*)lds_raw; F.ws = a.ws; F.ctl = (unsigned*)(a.ws + WS_CTL);
    F.tid = threadIdx.x; F.lane = F.tid & 63; F.wave = __builtin_amdgcn_readfirstlane(F.tid >> 6);
    F.G = gridDim.x; { const int bx = blockIdx.x; F.vcu = (F.G % 8 == 0) ? (bx % 8) * (F.G / 8) + bx / 8 : bx; }
    F.gw = F.vcu * 8 + F.wave; F.NGW = F.G * 8;
    volatile LAS unsigned* MISC = (volatile LAS unsigned*)(F.lds + MISC_OFF);
    for (int u = F.tid; u < (LDS_BYTES - RING_BYTES) / 4; u += 512) ((LAS unsigned*)(F.lds + RING_BYTES))[u] = 0u;
    __syncthreads();
    const int lo = a.ph_lo, hi = a.ph_hi;
    XcdBarrier bar; bar.bar = F.ctl + CW_BAR; bar.x = 0; bar.st = nullptr;
    if (hi - lo > 1) bar = xcd_barrier_post(F.ctl + CW_BAR, MISC + 8);
#ifndef PHASE_MASK
#define PHASE_MASK 0xffff
#endif
#define PH_ON(k) (((PHASE_MASK) >> (k)) & 1)
#define IN(k) (lo <= (k) && (k) < hi)
#define SEAM(k) do { if (IN(k) && IN((k) + 1)) xcd_barrier(bar); } while (0)
    const pg8::Prob nullp{nullptr, nullptr, 0, 0, 0, 0, 0};

    if (PH_ON(13) && IN(0)) for (int rep_ = 0; rep_ < REP(13); ++rep_) { F.relane(); prologue(F, a); }
    SEAM(0);
    for (int l = 0; l < DEPTH; ++l) {
        const int pb = 1 + l * NPH;
        if (PH_ON(0) && IN(pb + 0)) for (int rep_ = 0; rep_ < REP(0); ++rep_) {
            F.relane(); unsigned char* ws = F.ws;
            const pg8::Prob P0{l == 0 ? P_XB : P_X3, P_WL(WO_Z), DM, DM, DM, 24, 0};
            const pg8::Prob P1{l == 0 ? P_XB : P_X3, P_WL(WO_KR), DM, 512, 512, 8, 512};
            const pg8::Prob P2{(const bf16_t*)(ws + WS_PB) + (size_t)l * M * PLE, P_WL(WO_PLE), PLE, PLE, PLE, DM / 256, 0};
            pg8::Deal<3> S; S.init(P0, P1, P2, F.G, (int)blockIdx.x);
            const EpiZ E{P_QA, P_KA, P_VA, P_XR, P_GG, P_CQ, P_CKV, P_KRP, P_SSQ24, P_RSTD, P_C128, P_S128, P_ERAW, P_ESSQ};
            const bool cfirst = (blockIdx.x & 1) == 0;
            if (l == 0 && cfirst) { convert_items(F, a, CV_G1_0, CV_G1_1); __syncthreads(); }
            pg8::gemm_phase<3, EpiZ>(F.lds, F.wave, S, E);
            if (l == 0 && !cfirst) { __syncthreads(); convert_items(F, a, CV_G1_0, CV_G1_1); }
        }
        SEAM(pb + 0);
        if (PH_ON(2) && IN(pb + 2)) for (int rep_ = 0; rep_ < REP(2); ++rep_) {
            F.relane(); unsigned char* ws = F.ws;
            const pg8::Prob P0{P_CQ, P_WL(WO_UQ), QRANK, QRANK, QRANK, NQU / 256, 0};
            const pg8::Prob P1{P_CKV, P_WL(WO_UKV), KVRANK, KVRANK, KVRANK, NKVU / 256, 0};
            const pg8::Prob P2{P_XC, P_WL(WO_RG), RGW, 128, 128, 8, 128};
            pg8::Deal<3> S; S.init(P2, P0, P1, F.G, (int)blockIdx.x); S.rev = 8u;
            kr_finish(F, P_KRP, P_C64, P_S64, P_KR);
            { pg8::Unit u; for (int i = 0; pg8::deal_next<3>(S, i, u); ++i) if (u.p == 0) conv_tile(F.tid, u.pm, u.pn, P_XR, (const float*)a.in[I_CONVW] + l * 4 * RGW, (const float*)a.in[I_CONVB] + l * RGW, P_XC); }
            VM_WAIT(); __syncthreads();
            const EpiMid E{EpiUp{P_QN, P_QR, P_KVM, P_SSQ24, P_C64, P_S64}, EpiGate{(const float*)a.in[I_GAB] + l * RGW, (const float*)a.in[I_GXB] + l * RGW, (const float*)(ws + WS_C8) + l * RGW, P_XC, P_AA, P_BB}};
            pg8::gemm_phase<3, EpiMid>(F.lds, F.wave, S, E);
            __syncthreads();
            { pg8::Unit u; for (int i = 0; pg8::deal_next<3>(S, i, u); ++i) if (u.p == 0) scan_pass1_tile(F.tid, u.pm, u.pn, P_AA, P_BB, P_CP, P_CL); }
        }
        SEAM(pb + 2);
        if (PH_ON(4) && IN(pb + 4)) for (int rep_ = 0; rep_ < REP(4); ++rep_) {
            F.relane(); unsigned char* ws = F.ws;
            if (l == 0 && (blockIdx.x & 1) == 0) {
                const int rank = (int)(blockIdx.x >> 1);
                convert_items(F, a, CV_AT_0, CV_AT_1, rank * 8 + F.wave, (F.G / 2) * 8); __syncthreads(); }
            const float* sinks = (const float*)a.in[I_SINK] + l * 12;
            attn_phase<true>(F, F.ctl + CW_Q + 64 * (2 * l + 1 + 4 * rep_), 768, [&](int u, LAS char* L) {
                if (u < 384) {
                    const int qb = 7 - u / 48, rem = u % 48, b = rem / 12, h = rem % 12; const size_t r0 = (size_t)b * SEQ + qb * 256;
                    att::Tens T; T.Q = P_QN + r0 * 1536 + h * 128; T.qp = 1536; T.QR = P_QR + r0 * 768 + h * 64; T.qrp = 768; T.K = P_KVM + (size_t)b * SEQ * NKVU + h * 256; T.kp = NKVU;
                    T.V = T.K + 128; T.vp = NKVU; T.KR = P_KR + (size_t)b * SEQ * 64; T.O = P_OC + r0 * DM + 2560 + h * 128; T.op = DM; T.SS = P_GSS + r0 * 40 + 28 + h;
                    att::attn_unit<true>(L, F.wave, 0u, T, qb * 256, 1 << 30, -1e30f, 0.0f, 0.07216878364870323f);
                } else {
                    const int v = u - 384, b = v / 96, rem = v % 96, h = rem >> 3, qb = rem & 7; const size_t r0 = (size_t)b * SEQ + qb * 256;
                    att::Tens T; T.Q = P_QA + r0 * 1536 + h * 128; T.qp = 1536; T.QR = nullptr; T.qrp = 0; T.K = P_KA + (size_t)b * SEQ * 512 + (h / 3) * 128; T.kp = 512;
                    T.V = P_VA + (size_t)b * SEQ * 512 + (h / 3) * 128; T.vp = 512; T.KR = nullptr; T.O = P_OC + r0 * DM + h * 128; T.op = DM; T.SS = P_GSS + r0 * 40 + h;
                    att::attn_unit<false>(L, F.wave, 0u, T, qb * 256, 128, sinks[h] * 11.313708498984761f, 1.0f, 0.08838834764831845f);
                } });
            scan_pass2(F, P_AA, P_BB, P_CP, P_CL, P_GG, P_OC, P_GSS);
        }
        SEAM(pb + 4);
        if (PH_ON(6) && IN(pb + 6)) for (int rep_ = 0; rep_ < REP(6); ++rep_) {
            F.relane(); unsigned char* ws = F.ws;
            const pg8::Prob P{P_OC, P_WL(WO_OUT), DM, DM, DM, DM / 256, 0};
            pg8::Deal<1> S; S.init(P, nullp, nullp, F.G, (int)blockIdx.x);
            const EpiOut E{P_MO, P_RT};
            { pg8::Unit u; for (int i = 0; pg8::deal_next<1>(S, i, u); ++i) ratio_rows(F.tid, u.pm, P_GSS, P_RT); }
            __syncthreads();
            const bool cfirst = (blockIdx.x & 1) == 0;
            if (l == 0 && cfirst) { convert_items(F, a, CV_G3_0, CV_G3_1); __syncthreads(); }
            pg8::gemm_phase<1, EpiOut>(F.lds, F.wave, S, E);
            if (l == 0 && !cfirst) { __syncthreads(); convert_items(F, a, CV_G3_0, CV_G3_1); }
        }
        SEAM(pb + 6);
        if (PH_ON(7) && IN(pb + 7)) for (int rep_ = 0; rep_ < REP(7); ++rep_) { F.relane(); unsigned char* ws = F.ws;
            if (l == 0) residual_phase<false>(F, P_XB, P_MO, (const float*)a.in[I_POSTMIX] + l * DM, P_X1, P_RSTD, nullptr, nullptr);
            else residual_phase<false>(F, P_X3, P_MO, (const float*)a.in[I_POSTMIX] + l * DM, P_X1, P_RSTD, nullptr, nullptr); }
        SEAM(pb + 7);
        if (PH_ON(8) && IN(pb + 8)) for (int rep_ = 0; rep_ < REP(8); ++rep_) {
            F.relane(); unsigned char* ws = F.ws;
            const pg8::Prob P{P_X1, P_WL(WO_GU), DM, DM, DM, NGU / 256, 0};
            pg8::Deal<1> S; S.init(P, nullp, nullp, F.G, (int)blockIdx.x);
            const EpiGU E{P_ACT, P_RSTD};
            const bool cfirst = (blockIdx.x & 1) == 0;
            if (l == 0 && cfirst) { convert_items(F, a, CV_G4_0, CV_G4_1); __syncthreads(); }
            pg8::gemm_phase<1, EpiGU>(F.lds, F.wave, S, E);
            if (l == 0 && !cfirst) { __syncthreads(); convert_items(F, a, CV_G4_0, CV_G4_1); }
        }
        SEAM(pb + 8);
        if (PH_ON(9) && IN(pb + 9)) for (int rep_ = 0; rep_ < REP(9); ++rep_) {
            F.relane(); unsigned char* ws = F.ws;
            const pg8::Prob P{P_ACT, P_WL(WO_DN), DFF, DFF, DFF, DM / 256, 0};
            pg8::Deal<1> S; S.init(P, nullp, nullp, F.G, (int)blockIdx.x);
            const EpiF32S<true> E{P_MO, nullptr};
            pg8::gemm_phase<1, EpiF32S<true>>(F.lds, F.wave, S, E);
        }
        SEAM(pb + 9);
        if (PH_ON(10) && IN(pb + 10)) for (int rep_ = 0; rep_ < REP(10); ++rep_) { F.relane(); unsigned char* ws = F.ws;
            residual_phase<false>(F, P_X1, P_MO, (const float*)a.in[I_POSTFFN] + l * DM, P_XB, nullptr, P_ESSQ, P_ESC); }
        SEAM(pb + 10);
        if (PH_ON(11) && IN(pb + 11)) for (int rep_ = 0; rep_ < REP(11); ++rep_) {
            F.relane(); unsigned char* ws = F.ws;
            const pg8::Prob P{P_XB, P_WL(WO_PG), DM, DM, DM, DM / 256, 0};
            pg8::Deal<1> S; S.init(P, nullp, nullp, F.G, (int)blockIdx.x);
            if (l + 1 < DEPTH) { const EpiPG<false> E{P_XB, nullptr, rep_ ? P_MIX : P_X3, P_ERAW, P_ESC, (const float*)a.in[I_PLENORM] + l * DM, (const float*)a.in[I_BPG] + l * DM, rep_ ? P_ESSQ : P_SSQ64};
                pg8::gemm_phase<1, EpiPG<false>>(F.lds, F.wave, S, E); }
            else { const EpiPG<true> E{P_XB, a.out, nullptr, P_ERAW, P_ESC, (const float*)a.in[I_PLENORM] + l * DM, (const float*)a.in[I_BPG] + l * DM, nullptr};
                pg8::gemm_phase<1, EpiPG<true>>(F.lds, F.wave, S, E); }
        }
        if (l + 1 < DEPTH) {
            SEAM(pb + 11);
            if (PH_ON(12) && IN(pb + 12)) for (int rep_ = 0; rep_ < REP(12); ++rep_) { F.relane(); unsigned char* ws = F.ws; rstd_phase(F, P_SSQ64, P_RSTD); }
            SEAM(pb + 12);
        }
    }
#undef IN
#undef SEAM
}

extern "C" void kernel_launch(void* const* d_in, const int* in_sizes, int n_in, void* d_out, int out_size, void* d_ws, size_t ws_size, hipStream_t stream) {
    static int grid = 0;
    if (grid == 0) {
        if (n_in != NIN || out_size != M * DM || ws_size < WS_END) { fprintf(stderr, "kernel_launch: unexpected shapes (n_in %d, out %d, ws %zu < %zu)\n", n_in, out_size, ws_size, (size_t)WS_END); grid = -1; return; }
        int dev = 0, cus = 0, per_cu = 0;
        if (hipGetDevice(&dev) != hipSuccess || hipDeviceGetAttribute(&cus, hipDeviceAttributeMultiprocessorCount, dev) != hipSuccess) { grid = -1; return; }
        if (hipFuncSetAttribute((const void*)fwd, hipFuncAttributeMaxDynamicSharedMemorySize, LDS_BYTES) != hipSuccess) { fprintf(stderr, "kernel_launch: hipFuncSetAttribute failed\n"); grid = -1; return; }
        if (hipOccupancyMaxActiveBlocksPerMultiprocessor(&per_cu, (const void*)fwd, 512, LDS_BYTES) != hipSuccess || per_cu < 1) fprintf(stderr, "kernel_launch: occupancy query says %d\n", per_cu);
        (void)hipGetLastError();
        grid = cus;
    }
    if (grid < 0) return;
    (void)in_sizes;
    if (hipMemsetAsync((char*)d_ws + WS_CTL, 0, CTL_BYTES, stream) != hipSuccess) return;
    Args a{};
    for (int i = 0; i < NIN; ++i) a.in[i] = d_in[i];
    a.out = (float*)d_out; a.ws = (unsigned char*)d_ws;
    for (int i = 0; i < 64; ++i) a.inv128[i] = (float)pow(10000.0, -(double)i / 64.0);
    for (int i = 0; i < 32; ++i) a.inv64[i] = (float)pow(10000.0, -(double)i / 32.0);
#if MK_N_LAUNCHES == 1
    a.ph_lo = 0; a.ph_hi = N_PHASES;
    hipLaunchKernelGGL(fwd, dim3(grid), dim3(512), LDS_BYTES, stream, a);
#else
    for (int ph = 0; ph < N_PHASES; ++ph) { a.ph_lo = ph; a.ph_hi = ph + 1; hipLaunchKernelGGL(fwd, dim3(grid), dim3(512), LDS_BYTES, stream, a); }
#endif
}
```

```cpp
#include <hip/hip_runtime.h>
#include <cstdio>
#include <cstdint>
#include <cmath>

#ifndef MK_N_LAUNCHES
#define MK_N_LAUNCHES 1
#endif

#ifndef PROBE_REPEAT
#define PROBE_REPEAT -1
#endif
#define REP(k) ((PROBE_REPEAT == (k)) ? 2 : 1)
#define LAS __attribute__((address_space(3)))
#define GAS __attribute__((address_space(1)))
typedef unsigned short bf16_t;
typedef short bf16x8 __attribute__((ext_vector_type(8)));
typedef short s16x4 __attribute__((ext_vector_type(4)));
typedef float f32x4 __attribute__((ext_vector_type(4)));
typedef float f32x2 __attribute__((ext_vector_type(2)));
typedef float f32x16 __attribute__((ext_vector_type(16)));
typedef unsigned u32x4 __attribute__((ext_vector_type(4)));
typedef unsigned u32x2 __attribute__((ext_vector_type(2)));

constexpr int NB = 4, SEQ = 2048, M = NB * SEQ, DM = 4096, DEPTH = 2;
constexpr int NZ = 6208, NZP = 6400, DFF = 11008, NGU = 2 * DFF, PLE = 256;
constexpr int NQU = 2304, NKVU = 3072, QRANK = 1024, KVRANK = 512, RGW = 1024;
constexpr float EPS = 1e-6f;
constexpr int NIN = 29;

constexpr size_t al4k(size_t x) { return (x + 4095) & ~(size_t)4095; }
constexpr size_t WS_CTL = 0, CTL_BYTES = 1u << 20;
constexpr size_t WO_Z = 0;
constexpr size_t WO_KR = WO_Z + (size_t)6144 * DM * 2;
constexpr size_t WO_UQ = WO_Z + (size_t)NZP * DM * 2;
static_assert(WO_KR + (size_t)8 * 256 * 512 * 2 <= WO_UQ, "k_r slices fit behind the main z copy");
constexpr size_t WO_UKV = WO_UQ + (size_t)NQU * QRANK * 2;
constexpr size_t WO_RG = WO_UKV + (size_t)NKVU * KVRANK * 2;
constexpr size_t WO_OUT = WO_RG + (size_t)2048 * 128 * 2;
constexpr size_t WO_GU = WO_OUT + (size_t)DM * DM * 2;
constexpr size_t WO_DN = WO_GU + (size_t)NGU * DM * 2;
constexpr size_t WO_PLE = WO_DN + (size_t)DM * DFF * 2;
constexpr size_t WO_PG = WO_PLE + (size_t)DM * PLE * 2;
constexpr size_t W_LAYER = al4k(WO_PG + (size_t)DM * DM * 2);
constexpr size_t WS_W = WS_CTL + CTL_BYTES;
constexpr size_t WS_R1 = WS_W + 2 * W_LAYER;
constexpr size_t R1_QA = 0, R1_KA = R1_QA + (size_t)M * 1536 * 2, R1_VA = R1_KA + (size_t)M * 512 * 2, R1_XR = R1_VA + (size_t)M * 512 * 2;
constexpr size_t R1_GG = R1_XR + (size_t)M * 1024 * 2, R1_CQ = R1_GG + (size_t)M * 1024 * 2, R1_CKV = R1_CQ + (size_t)M * 1024 * 2, R1_KR = R1_CKV + (size_t)M * 512 * 2;
constexpr size_t R1_QN = R1_KR + (size_t)M * 64 * 2, R1_QR = R1_QN + (size_t)M * 1536 * 2, R1_XC = R1_QR + (size_t)M * 768 * 2, R1_END = R1_XC + (size_t)M * 1024 * 2;
constexpr size_t R1_BYTES = al4k((size_t)M * DFF * 2);
static_assert(R1_END <= R1_BYTES, "R1 overlay");
constexpr size_t WS_R2 = WS_R1 + R1_BYTES;
constexpr size_t R2_KVM = 0, R2_AA = R2_KVM + (size_t)M * NKVU * 2, R2_BB = R2_AA + (size_t)M * 1024 * 4, R2_END = R2_BB + (size_t)M * 1024 * 4;
constexpr size_t R2_BYTES = (size_t)M * DM * 4;
static_assert(R2_END + (size_t)8 * M * 64 * 4 <= R2_BYTES, "R2 overlay + k_r partials");
constexpr size_t WS_OC = WS_R2 + R2_BYTES;
constexpr size_t WS_MIX = WS_OC + (size_t)M * DM * 2;
constexpr size_t WS_GSS = WS_MIX;
constexpr size_t WS_RT = WS_GSS + (size_t)M * 40 * 4;
constexpr size_t WS_XB = WS_MIX + (size_t)M * DM * 2;
constexpr size_t WS_ERAW = WS_XB + (size_t)M * DM * 2;
constexpr size_t WS_SSQ24 = WS_ERAW + (size_t)M * DM * 4;
constexpr size_t WS_SSQ64 = WS_SSQ24 + (size_t)M * 24 * 4;
constexpr size_t WS_ESSQ = WS_SSQ64 + (size_t)M * 64 * 4;
constexpr size_t WS_RSTD = WS_ESSQ + (size_t)M * 64 * 4;
constexpr size_t WS_ESC = WS_RSTD + (size_t)M * 4;
constexpr size_t WS_CP = WS_ESC + (size_t)M * 4;
constexpr size_t WS_CL = WS_CP + (size_t)NB * 32 * 1024 * 4;
constexpr size_t WS_COS128 = WS_CL + (size_t)NB * 32 * 1024 * 4;
constexpr size_t WS_SIN128 = WS_COS128 + (size_t)M * 64 * 4;
constexpr size_t WS_COS64 = WS_SIN128 + (size_t)M * 64 * 4;
constexpr size_t WS_SIN64 = WS_COS64 + (size_t)M * 32 * 4;
constexpr size_t WS_PB = WS_SIN64 + (size_t)M * 32 * 4;
constexpr size_t WS_C8 = WS_PB + (size_t)DEPTH * M * PLE * 2;
constexpr size_t WS_END = al4k(WS_C8 + (size_t)DEPTH * RGW * 4);

constexpr int CW_BAR = 4096;
constexpr int CW_Q = 16384;

constexpr int RING_BYTES = 131072;
constexpr int MISC_OFF = RING_BYTES + 320;
constexpr int LDS_BYTES = 147456;

__device__ __forceinline__ unsigned cvt_pk_bf16(float lo, float hi) { unsigned r; asm("v_cvt_pk_bf16_f32 %0, %1, %2" : "=v"(r) : "v"(lo), "v"(hi)); return r; }
__device__ __forceinline__ float bf2f(unsigned short b) { return __uint_as_float(((unsigned)b) << 16); }
__device__ __forceinline__ float bflo(unsigned w) { return __uint_as_float(w << 16); }
__device__ __forceinline__ float bfhi(unsigned w) { return __uint_as_float(w & 0xffff0000u); }
__device__ __forceinline__ float wave_sum(float v) {
#pragma unroll
    for (int o = 1; o < 64; o <<= 1) v += __shfl_xor(v, o);
    return v;
}
template <int N, int LEN>
__device__ __forceinline__ void rs_step(float (&v)[LEN], bool up, int mask) {
#pragma unroll
    for (int i = 0; i < N; ++i) { const float send = up ? v[i] : v[i + N], keep = up ? v[i + N] : v[i]; v[i] = keep + __shfl_xor(send, mask); }
}
__device__ __forceinline__ float dot4(f32x4 v) { return (v.x * v.x + v.y * v.y) + (v.z * v.z + v.w * v.w); }
__device__ __forceinline__ float sigmoidf_(float x) { return __builtin_amdgcn_rcpf(1.0f + __builtin_amdgcn_exp2f(-1.4426950408889634f * x)); }
__device__ __forceinline__ float gelu_tanh(float x) { const float u = 0.7978845608028654f * (x + 0.044715f * x * x * x); return x * sigmoidf_(2.0f * u); }
__device__ __forceinline__ int otid(int wv) { int l = (int)__builtin_amdgcn_mbcnt_hi(~0u, __builtin_amdgcn_mbcnt_lo(~0u, 0u)); asm volatile("" : "+v"(l)); return (wv << 6) | l; }
__device__ __forceinline__ unsigned char* oweak(unsigned char* p) { size_t z = 0; asm volatile("" : "+s"(z)); return p + z; }
#define LDS_WAIT() asm volatile("s_waitcnt lgkmcnt(0)" ::: "memory")
#define VM_WAIT() asm volatile("s_waitcnt vmcnt(0)" ::: "memory")

#define XB_TMO      128
#define XB_XCNT(j)  (256  + 64 * (j))
#define XB_XSUB(j)  (1280 + 64 * (j))
#define XB_XGEN(j)  (2304 + 64 * (j))
#define XB_TOP      3328
#define XB_TOPGEN   3392
#define XCD_BAR_WORDS 3456
#define XB_SPIN_CAP (1u << 18)
__device__ __forceinline__ unsigned xb_ld(unsigned* p)              { return __hip_atomic_load(p, __ATOMIC_RELAXED, __HIP_MEMORY_SCOPE_AGENT); }
__device__ __forceinline__ unsigned xb_add(unsigned* p, unsigned v) { return __hip_atomic_fetch_add(p, v, __ATOMIC_RELAXED, __HIP_MEMORY_SCOPE_AGENT); }
__device__ __forceinline__ unsigned xb_xcc_id() { return (unsigned)__builtin_amdgcn_s_getreg((3 << 11) | 20) & 0xFu; }
#define XB_SPIN(cond, bar) do { unsigned _sp = 0; while (cond) { __builtin_amdgcn_s_sleep(1); \
    if ((++_sp & 255u) == 0u) { if (xb_ld(&(bar)[XB_TMO])) break; if (_sp > XB_SPIN_CAP) { atomicAdd(&(bar)[XB_TMO], 1u); break; } } } } while (0)
struct XcdBarrier { unsigned* bar; unsigned x; volatile LAS unsigned* st; };
__device__ __forceinline__ XcdBarrier xcd_barrier_post(unsigned* bar, volatile LAS unsigned* st) {
    XcdBarrier b; b.bar = bar; b.x = xb_xcc_id(); b.st = st;
    if (threadIdx.x == 0) (void)xb_add(&bar[XB_XCNT(b.x)], 1u);
    return b;
}
__device__ __forceinline__ void xcd_barrier_complete(unsigned* bar, unsigned x, unsigned& nloc, unsigned& nx) {
    const unsigned G = gridDim.x * gridDim.y * gridDim.z;
    unsigned sum, cnt, mine, sp = 0u;
    for (;;) {
        sum = 0u; cnt = 0u; mine = 0u;
#pragma unroll
        for (unsigned j = 0; j < 16; ++j) { const unsigned c = xb_ld(&bar[XB_XCNT(j)]); sum += c; cnt += (c > 0u) ? 1u : 0u; mine = (j == x) ? c : mine; }
        if (sum == G) break;
        __builtin_amdgcn_s_sleep(1);
        if ((++sp & 255u) == 0u) { if (xb_ld(&bar[XB_TMO])) break; if (sp > XB_SPIN_CAP) { atomicAdd(&bar[XB_TMO], 1u); break; } }
    }
    nloc = mine > 0u ? mine : 1u; nx = cnt > 0u ? cnt : 1u;
}
__device__ __forceinline__ void xcd_barrier(const XcdBarrier& b) {
    asm volatile("s_waitcnt vmcnt(0)" ::: "memory");
    __syncthreads();
    if (threadIdx.x == 0) {
        unsigned* bar = b.bar;
        __builtin_amdgcn_s_waitcnt(0);
        unsigned nloc = b.st[0], nx = b.st[1];
        if (nloc == 0u) { xcd_barrier_complete(bar, b.x, nloc, nx); b.st[0] = nloc; b.st[1] = nx; }
        const unsigned old = xb_add(&bar[XB_XSUB(b.x)], 1u);
        const unsigned gen = old / nloc;
        if (old + 1u == (gen + 1u) * nloc) {
            __builtin_amdgcn_fence(__ATOMIC_RELEASE, "agent");
            asm volatile("s_waitcnt vmcnt(0)" ::: "memory");
            const unsigned og = xb_add(&bar[XB_TOP], 1u);
            const unsigned tg = og / nx;
            if (og + 1u == (tg + 1u) * nx) xb_add(&bar[XB_TOPGEN], 1u);
            else XB_SPIN(xb_ld(&bar[XB_TOPGEN]) == tg, bar);
            __builtin_amdgcn_fence(__ATOMIC_ACQUIRE, "agent");
            xb_add(&bar[XB_XGEN(b.x)], 1u);
            asm volatile("s_waitcnt vmcnt(0)" ::: "memory");
        } else {
            XB_SPIN(xb_ld(&bar[XB_XGEN(b.x)]) == gen, bar);
            __builtin_amdgcn_fence(__ATOMIC_ACQUIRE, "agent");
            asm volatile("s_waitcnt vmcnt(0)" ::: "memory");
        }
    }
    __syncthreads();
}

namespace pg8 {
constexpr int BM = 256, BK = 64, HALF = 128, HTB = HALF * BK * 2, NXCD = 8, WGM = 8;
__host__ __device__ __forceinline__ int lds_byte(int r, int c) { const int st = (r >> 4) * 2 + (c >> 5), rr = r & 15, cc = c & 31, ob = rr * 64 + cc * 2; return st * 1024 + (ob ^ (((ob >> 9) & 1) << 5)); }
__host__ __device__ __forceinline__ void stage_rc(int b, int& R, int& C) { const int st = b / 1024, sb = b % 1024, swz = sb ^ (((sb >> 9) & 1) << 5); R = (st >> 1) * 16 + swz / 64; C = (st & 1) * 32 + (swz % 64) / 2; }

struct Prob { const bf16_t* A; const bf16_t* Bt; int lda, ldb, K, nN, a_pn; };
constexpr int NM = M / BM;
struct Unit { int p, pm, pn; const char* A; const char* B; int lda2, ldb2, nt; };

template <int NP>
struct Deal {
    Prob P0, P1, P2; int G, c, n0, n1, n2, T; unsigned rev = 0;
    __device__ __forceinline__ void init(const Prob& a, const Prob& b, const Prob& d, int G_, int c_) { P0 = a; P1 = b; P2 = d; G = G_; c = c_; n0 = NM * a.nN; n1 = NP > 1 ? NM * b.nN : 0; n2 = NP > 2 ? NM * d.nN : 0; T = n0 + n1 + n2; }
};
template <int NP>
__device__ __forceinline__ bool deal_next(const Deal<NP> S, int i, Unit& u) {
    {
        const Prob P0 = S.P0, P1 = S.P1, P2 = S.P2; const int G = S.G, c = S.c, n0 = S.n0, n1 = S.n1, n2 = S.n2, T = S.T;
        const int L = i * G + (((S.rev >> i) & 1u) ? G - 1 - c : c); if (L >= T) return false;
        int p = 0, l = L, nw = n0;
        if (NP > 1 && L >= n0) { p = 1; l = L - n0; nw = n1; }
        if (NP > 2 && L >= n0 + n1) { p = 2; l = L - n0 - n1; nw = n2; }
#define PG8_PICK(f) ((NP == 1 || p == 0) ? P0.f : ((NP == 2 || p == 1) ? P1.f : P2.f))
        const int nN = PG8_PICK(nN);
        int wgid = l; { const int q = nw / NXCD, r = nw % NXCD, xcd = wgid % NXCD, off = wgid / NXCD; wgid = (xcd < r ? xcd * (q + 1) : r * (q + 1) + (xcd - r) * q) + off; }
        const int nig = WGM * nN, gid = wgid / nig, fm = gid * WGM, gsz = (NM - fm) < WGM ? (NM - fm) : WGM;
        u.p = p; u.pm = fm + ((wgid % nig) % gsz); u.pn = (wgid % nig) / gsz;
        u.lda2 = PG8_PICK(lda) * 2; u.ldb2 = PG8_PICK(ldb) * 2; u.nt = PG8_PICK(K) / BK;
        u.lda2 = __builtin_amdgcn_readfirstlane(u.lda2); u.ldb2 = __builtin_amdgcn_readfirstlane(u.ldb2); u.nt = __builtin_amdgcn_readfirstlane(u.nt);
        asm volatile("" : "+s"(u.lda2), "+s"(u.ldb2), "+s"(u.nt));
        u.A = (const char*)PG8_PICK(A) + (size_t)u.pm * BM * u.lda2 + (size_t)u.pn * PG8_PICK(a_pn) * 2;
        u.B = (const char*)PG8_PICK(Bt) + (size_t)u.pn * BM * u.ldb2;
#undef PG8_PICK
        return true;
    }
}

template <int NP, class Epi>
__device__ __forceinline__ void gemm_phase(LAS unsigned char* lds, int wv, const Deal<NP> S, const Epi E) {
    const int tid = otid(wv), wid = __builtin_amdgcn_readfirstlane(tid >> 6), lane = tid & 63, wr = wid >> 2, wc = wid & 3, fr = lane & 15, fq = lane >> 4;
    int R0, C0; stage_rc(tid * 16, R0, C0);
    const unsigned c0b = (unsigned)C0 * 2u;
    const unsigned ldsw = (unsigned)wid * 1024u;
    const int aoff = lds_byte(wr * 64 + fr, fq * 8), boff = lds_byte(wc * 32 + fr, fq * 8);
#define PG8_SA(b, h) (((b) * 2 + (h)) * HTB)
#define PG8_SB(b, h) ((4 + (b) * 2 + (h)) * HTB)
#define PG8_STAGE(bufoff, gbase, ld2) do { const unsigned _vo = (unsigned)R0 * (unsigned)(ld2) + c0b; const char* _g = (const char*)(gbase); \
        __builtin_amdgcn_global_load_lds((const unsigned*)(_g + _vo), (LAS unsigned*)(lds + (bufoff) + ldsw), 16, 0, 0); \
        __builtin_amdgcn_global_load_lds((const unsigned*)(_g + (size_t)64 * (ld2) + _vo), (LAS unsigned*)(lds + (bufoff) + ldsw + 8192), 16, 0, 0); } while (0)
#define PG8_LDA(dst, b, h) do { _Pragma("unroll") for (int m = 0; m < 4; ++m) _Pragma("unroll") for (int k = 0; k < 2; ++k) dst[m][k] = *(const LAS bf16x8*)(lds + PG8_SA(b, h) + aoff + m * 2048 + k * 1024); } while (0)
#define PG8_LDB(dst, b, h) do { _Pragma("unroll") for (int n = 0; n < 2; ++n) _Pragma("unroll") for (int k = 0; k < 2; ++k) dst[n][k] = *(const LAS bf16x8*)(lds + PG8_SB(b, h) + boff + n * 2048 + k * 1024); } while (0)
#define PG8_MMA(ai, bj, At, Bt) do { __builtin_amdgcn_s_setprio(1); _Pragma("unroll") for (int m = 0; m < 4; ++m) _Pragma("unroll") for (int n = 0; n < 2; ++n) _Pragma("unroll") for (int k = 0; k < 2; ++k) \
        acc[ai][bj][m][n] = __builtin_amdgcn_mfma_f32_16x16x32_bf16(Bt[n][k], At[m][k], acc[ai][bj][m][n], 0, 0, 0); __builtin_amdgcn_s_setprio(0); } while (0)
#define PG8_WAIT_V(n) asm volatile("s_waitcnt vmcnt(" #n ")" ::: "memory")
#define PG8_WAIT_L(n) asm volatile("s_waitcnt lgkmcnt(" #n ")" ::: "memory")
#define PG8_BAR __builtin_amdgcn_s_barrier()
#define PG8_SCHED __builtin_amdgcn_sched_barrier(0)
    Unit cur, nxt; int ui = 0;
    if (!deal_next<NP>(S, 0, cur)) return;
    f32x4 acc[2][2][4][2];
#pragma unroll
    for (int a = 0; a < 2; ++a)
#pragma unroll
        for (int b = 0; b < 2; ++b)
#pragma unroll
            for (int m = 0; m < 4; ++m)
#pragma unroll
                for (int n = 0; n < 2; ++n) acc[a][b][m][n] = (f32x4){0.f, 0.f, 0.f, 0.f};
    bf16x8 At[4][2], B0[2][2], B1[2][2];
    float pre[8] = {0.f, 0.f, 0.f, 0.f, 0.f, 0.f, 0.f, 0.f};
    const size_t kstep = (size_t)(BK * 2);
    {
        const char* cA = cur.A; const char* cB = cur.B; const size_t hA = (size_t)HALF * cur.lda2, hB = (size_t)HALF * cur.ldb2;
        PG8_STAGE(PG8_SB(0, 0), cB, cur.ldb2); PG8_STAGE(PG8_SB(0, 1), cB + hB, cur.ldb2); PG8_STAGE(PG8_SA(0, 0), cA, cur.lda2); PG8_STAGE(PG8_SA(0, 1), cA + hA, cur.lda2);
        if (wr == 1) PG8_BAR;
        PG8_WAIT_V(2); PG8_BAR;
        PG8_STAGE(PG8_SB(1, 0), cB + kstep, cur.ldb2); PG8_STAGE(PG8_SA(1, 0), cA + kstep, cur.lda2); PG8_STAGE(PG8_SB(1, 1), cB + hB + kstep, cur.ldb2);
        PG8_WAIT_V(6); PG8_BAR;
    }
    for (;;) {
        const bool has_next = deal_next<NP>(S, ui + 1, nxt);
        if (!has_next) nxt = cur;
        const char* cA = cur.A; const char* cB = cur.B; const int lda2 = cur.lda2, ldb2 = cur.ldb2, nt = cur.nt;
        const size_t hA = (size_t)HALF * lda2;
        for (int t = 0; t < nt; t += 2) {
            const bool last = (t == nt - 2);
            const char* a1 = cA + (size_t)(t + 1) * kstep;
            const char* a2 = last ? nxt.A : cA + (size_t)(t + 2) * kstep; const char* b2 = last ? nxt.B : cB + (size_t)(t + 2) * kstep;
            const int la = last ? nxt.lda2 : lda2, lb = last ? nxt.ldb2 : ldb2;
            const size_t hA2 = (size_t)HALF * la, hB2 = (size_t)HALF * lb;
            const char* a3 = a2 + kstep; const char* b3 = b2 + kstep;
            E.kstep(acc, pre, t, cur.pm, wr, fr);
            if (last) E.prefetch(pre, cur.p, cur.pm, cur.pn, wr, fr);
            PG8_LDB(B0, 0, 0); PG8_LDB(B1, 0, 1); PG8_SCHED; PG8_LDA(At, 0, 0); PG8_STAGE(PG8_SA(1, 1), a1 + hA, lda2);
            PG8_WAIT_V(8); PG8_WAIT_L(0); PG8_BAR; PG8_MMA(0, 0, At, B0); PG8_MMA(0, 1, At, B1); PG8_BAR; PG8_SCHED;
            PG8_LDA(At, 0, 1); PG8_STAGE(PG8_SB(0, 0), b2, lb); PG8_STAGE(PG8_SB(0, 1), b2 + hB2, lb); PG8_STAGE(PG8_SA(0, 0), a2, la);
            PG8_WAIT_V(8); PG8_WAIT_L(0); PG8_BAR; PG8_MMA(1, 0, At, B0); PG8_MMA(1, 1, At, B1); PG8_BAR; PG8_SCHED;
            PG8_LDB(B0, 1, 0); PG8_LDB(B1, 1, 1); PG8_SCHED; PG8_LDA(At, 1, 0); PG8_STAGE(PG8_SA(0, 1), a2 + hA2, la);
            PG8_WAIT_V(8); PG8_WAIT_L(0); PG8_BAR; PG8_MMA(0, 0, At, B0); PG8_MMA(0, 1, At, B1); PG8_BAR; PG8_SCHED;
            PG8_LDA(At, 1, 1); PG8_STAGE(PG8_SB(1, 0), b3, lb); PG8_STAGE(PG8_SB(1, 1), b3 + hB2, lb); PG8_STAGE(PG8_SA(1, 0), a3, la);
            PG8_WAIT_V(8); PG8_WAIT_L(0); PG8_BAR; PG8_MMA(1, 0, At, B0); PG8_MMA(1, 1, At, B1); PG8_BAR; PG8_SCHED;
        }
        if (wr == 0) PG8_BAR;
        E(acc, pre, cur.p, cur.pm, cur.pn, wr, wc, fr, fq);
        if (!has_next) break;
#pragma unroll
        for (int a = 0; a < 2; ++a)
#pragma unroll
            for (int b = 0; b < 2; ++b)
#pragma unroll
                for (int m = 0; m < 4; ++m)
#pragma unroll
                    for (int n = 0; n < 2; ++n) acc[a][b][m][n] = (f32x4){0.f, 0.f, 0.f, 0.f};
        cur = nxt; ++ui;
        if (wr == 1) PG8_BAR;
    }
    PG8_WAIT_V(0);
    PG8_BAR;
#undef PG8_SA
#undef PG8_SB
#undef PG8_STAGE
#undef PG8_LDA
#undef PG8_LDB
#undef PG8_MMA
#undef PG8_WAIT_V
#undef PG8_WAIT_L
#undef PG8_BAR
#undef PG8_SCHED
}
}
typedef f32x4 Acc[2][2][4][2];

#define EPI_ARGS const Acc& acc, const float (&pre)[8], int p, int pm, int pn, int wr, int wc, int fr, int fq
#define EPI_NOKSTEP __device__ __forceinline__ void kstep(Acc&, float (&)[8], int, int, int, int) const {}
#define EPI_NOPRE EPI_NOKSTEP __device__ __forceinline__ void prefetch(float (&)[8], int, int, int, int, int) const {}
template <bool BF>
struct EpiF32S {
    static constexpr bool AFTER_DRAIN = false;
    EPI_NOPRE
    void* C; float* ssq;
    __device__ __forceinline__ void operator()(EPI_ARGS) const {
        const int row0 = pm * 256 + wr * 64 + fr, col0 = pn * 256 + wc * 32 + 8 * fq;
#pragma unroll
        for (int ai = 0; ai < 2; ++ai)
#pragma unroll
            for (int m = 0; m < 4; ++m) {
                const int row = row0 + ai * 128 + m * 16; float s = 0.f;
#pragma unroll
                for (int bj = 0; bj < 2; ++bj) {
                    const f32x4 v0 = acc[ai][bj][m][0], v1 = acc[ai][bj][m][1]; s += dot4(v0) + dot4(v1);
                    if (BF) { u32x4 w; w.x = cvt_pk_bf16(v0[0], v0[1]); w.y = cvt_pk_bf16(v0[2], v0[3]); w.z = cvt_pk_bf16(v1[0], v1[1]); w.w = cvt_pk_bf16(v1[2], v1[3]);
                        *(u32x4*)((bf16_t*)C + (size_t)row * DM + col0 + bj * 128) = w; }
                    else { float* rp = (float*)C + (size_t)row * DM + col0 + bj * 128; *(f32x4*)rp = v0; *(f32x4*)(rp + 4) = v1; }
                }
                if (ssq) { s += __shfl_xor(s, 16); s += __shfl_xor(s, 32); if (fq == 0) ssq[(size_t)row * 64 + pn * 4 + wc] = s; }
            }
    }
};
struct EpiOut {
    static constexpr bool AFTER_DRAIN = false;
    bf16_t* C; const float* RT;
    __device__ __forceinline__ void prefetch(float (&pr)[8], int, int pm, int, int wr, int fr) const {
#pragma unroll
        for (int g = 0; g < 8; ++g) pr[g] = RT[(size_t)(pm * 256 + wr * 64 + fr + (g >> 2) * 128 + (g & 3) * 16) * 4 + 2];
    }
    __device__ __forceinline__ void kstep(Acc& acc, float (&)[8], int t, int pm, int wr, int fr) const {
        if (t == 24 || t == 40) {
            int rb = (pm * 256 + wr * 64 + fr) * 4 + (t == 24 ? 0 : 1); asm volatile("" : "+v"(rb));
            float q[8];
#pragma unroll
            for (int g = 0; g < 8; ++g) q[g] = RT[rb + ((g >> 2) * 128 + (g & 3) * 16) * 4];
#pragma unroll
            for (int ai = 0; ai < 2; ++ai)
#pragma unroll
                for (int m = 0; m < 4; ++m)
#pragma unroll
                    for (int bj = 0; bj < 2; ++bj)
#pragma unroll
                        for (int n = 0; n < 2; ++n) acc[ai][bj][m][n] *= q[ai * 4 + m];
        }
    }
    __device__ __forceinline__ void operator()(EPI_ARGS) const {
        const int row0 = pm * 256 + wr * 64 + fr, col0 = pn * 256 + wc * 32 + 8 * fq;
#pragma unroll
        for (int ai = 0; ai < 2; ++ai)
#pragma unroll
            for (int m = 0; m < 4; ++m) {
                const int row = row0 + ai * 128 + m * 16; const float q = pre[ai * 4 + m];
#pragma unroll
                for (int bj = 0; bj < 2; ++bj) {
                    const f32x4 v0 = acc[ai][bj][m][0] * q, v1 = acc[ai][bj][m][1] * q;
                    u32x4 w; w.x = cvt_pk_bf16(v0[0], v0[1]); w.y = cvt_pk_bf16(v0[2], v0[3]); w.z = cvt_pk_bf16(v1[0], v1[1]); w.w = cvt_pk_bf16(v1[2], v1[3]);
                    *(u32x4*)(C + (size_t)row * DM + col0 + bj * 128) = w;
                }
            }
    }
};
__device__ __forceinline__ void ratio_rows(int tid, int pm, const float* GSS, float* RT) {
    if (tid < 256) {
        const int row = pm * 256 + tid; const f32x4* g = (const f32x4*)(GSS + (size_t)row * 40);
        f32x4 v[10];
#pragma unroll
        for (int j = 0; j < 10; ++j) v[j] = g[j];
        const f32x4 a4 = v[0] + v[1] + v[2], b4 = (v[3] + v[4]) + (v[5] + v[6]), c4 = v[7] + v[8] + v[9];
        const float sa = (a4.x + a4.y) + (a4.z + a4.w), sb = (b4.x + b4.y) + (b4.z + b4.w), sc = (c4.x + c4.y) + (c4.z + c4.w);
        const float ia = sqrtf(sa * (1.0f / 1536) + EPS), ib = sqrtf(sb * (1.0f / 1024) + EPS), ic = sqrtf(sc * (1.0f / 1536) + EPS);
        *(f32x4*)(RT + (size_t)row * 4) = (f32x4){ib / ia, ic / ib, 1.0f / ic, 0.f};
    }
}
struct EpiGU {
    static constexpr bool AFTER_DRAIN = false;
    bf16_t* ACT; const float* rstd;
    EPI_NOKSTEP
    __device__ __forceinline__ void prefetch(float (&pr)[8], int, int pm, int, int wr, int fr) const {
#pragma unroll
        for (int g = 0; g < 8; ++g) pr[g] = rstd[pm * 256 + wr * 64 + fr + (g >> 2) * 128 + (g & 3) * 16]; }
    __device__ __forceinline__ void operator()(EPI_ARGS) const {
        const int row0 = pm * 256 + wr * 64 + fr, f0 = pn * 128 + wc * 32 + 8 * fq;
#pragma unroll
        for (int ai = 0; ai < 2; ++ai)
#pragma unroll
            for (int m = 0; m < 4; ++m) {
                const int row = row0 + ai * 128 + m * 16; const float rs = pre[ai * 4 + m]; float a[2][4];
#pragma unroll
                for (int bj = 0; bj < 2; ++bj) {
                    const f32x4 g = acc[ai][bj][m][0] * rs, u = acc[ai][bj][m][1] * rs;
#pragma unroll
                    for (int j = 0; j < 4; ++j) a[bj][j] = g[j] * sigmoidf_(g[j]) * u[j];
                }
                u32x4 w; w.x = cvt_pk_bf16(a[0][0], a[0][1]); w.y = cvt_pk_bf16(a[0][2], a[0][3]); w.z = cvt_pk_bf16(a[1][0], a[1][1]); w.w = cvt_pk_bf16(a[1][2], a[1][3]);
                *(u32x4*)(ACT + (size_t)row * DFF + f0) = w;
            }
    }
};
template <bool LAST>
struct EpiPG {
    static constexpr bool AFTER_DRAIN = false;
    EPI_NOKSTEP
    __device__ __forceinline__ void prefetch(float (&pr)[8], int, int pm, int, int wr, int fr) const {
#pragma unroll
        for (int g = 0; g < 8; ++g) pr[g] = esc[pm * 256 + wr * 64 + fr + (g >> 2) * 128 + (g & 3) * 16]; }
    const bf16_t* X2; float* OUT; bf16_t* X3; const bf16_t* ERAW; const float* esc; const float* pg; const float* bias; float* ssq;
    __device__ __forceinline__ void operator()(EPI_ARGS) const {
        const int row0 = pm * 256 + wr * 64 + fr, col0 = pn * 256 + wc * 32 + 8 * fq;
        f32x4 bv[2][2], gv[2][2];
#pragma unroll
        for (int bj = 0; bj < 2; ++bj)
#pragma unroll
            for (int n = 0; n < 2; ++n) { bv[bj][n] = *(const f32x4*)(bias + col0 + bj * 128 + n * 4); gv[bj][n] = *(const f32x4*)(pg + col0 + bj * 128 + n * 4); }
        u32x4 xb[2][2], eb[2][2]; float es[2];
#define PG_LOAD(g, buf) do { const size_t off_ = (size_t)(row0 + ((g) >> 2) * 128 + ((g) & 3) * 16) * DM + col0; es[buf] = pre[g]; \
        _Pragma("unroll") for (int bj = 0; bj < 2; ++bj) { xb[buf][bj] = *(const u32x4*)(X2 + off_ + bj * 128); eb[buf][bj] = *(const u32x4*)(ERAW + off_ + bj * 128); } } while (0)
        PG_LOAD(0, 0);
#pragma unroll
        for (int g = 0; g < 8; ++g) {
            const int ai = g >> 2, m = g & 3, buf = g & 1;
            if (g + 1 < 8) PG_LOAD(g + 1, buf ^ 1);
            asm volatile("" ::: "memory");
            const int row = row0 + ai * 128 + m * 16; const size_t off = (size_t)row * DM + col0; float s = 0.f;
#pragma unroll
            for (int bj = 0; bj < 2; ++bj) {
                f32x4 o[2];
#pragma unroll
                for (int n = 0; n < 2; ++n) {
                    const f32x4 a = acc[ai][bj][m][n] + bv[bj][n];
                    const unsigned xw0 = n ? xb[buf][bj].z : xb[buf][bj].x, xw1 = n ? xb[buf][bj].w : xb[buf][bj].y, ew0 = n ? eb[buf][bj].z : eb[buf][bj].x, ew1 = n ? eb[buf][bj].w : eb[buf][bj].y;
                    const f32x4 x2 = {bflo(xw0), bfhi(xw0), bflo(xw1), bfhi(xw1)}, e = {bflo(ew0), bfhi(ew0), bflo(ew1), bfhi(ew1)};
#pragma unroll
                    for (int j = 0; j < 4; ++j) o[n][j] = x2[j] + sigmoidf_(a[j]) * (e[j] * es[buf] * gv[bj][n][j]);
                }
                if (LAST) { float* rp = OUT + off + bj * 128; *(f32x4*)rp = o[0]; *(f32x4*)(rp + 4) = o[1]; }
                else { s += dot4(o[0]) + dot4(o[1]); u32x4 w; w.x = cvt_pk_bf16(o[0][0], o[0][1]); w.y = cvt_pk_bf16(o[0][2], o[0][3]); w.z = cvt_pk_bf16(o[1][0], o[1][1]); w.w = cvt_pk_bf16(o[1][2], o[1][3]);
                    *(u32x4*)(X3 + off + bj * 128) = w; }
            }
            if (!LAST) { s += __shfl_xor(s, 16); s += __shfl_xor(s, 32); if (fq == 0) ssq[(size_t)row * 64 + pn * 4 + wc] = s; }
            asm volatile("" ::: "memory");
        }
#undef PG_LOAD
    }
};
__device__ __forceinline__ void st_plain8(bf16_t* rp, const f32x4 v0, const f32x4 v1) {
    u32x4 w; w.x = cvt_pk_bf16(v0[0], v0[1]); w.y = cvt_pk_bf16(v0[2], v0[3]); w.z = cvt_pk_bf16(v1[0], v1[1]); w.w = cvt_pk_bf16(v1[2], v1[3]);
    *(u32x4*)rp = w;
}
__device__ __forceinline__ void st_rope8(bf16_t* rp, int half, const f32x4 x1a, const f32x4 x1b, const f32x4 x2a, const f32x4 x2b, const f32x4 ca, const f32x4 cb, const f32x4 sa, const f32x4 sb) {
    const f32x4 y1a = x1a * ca - x2a * sa, y1b = x1b * cb - x2b * sb, y2a = x2a * ca + x1a * sa, y2b = x2b * cb + x1b * sb;
    u32x4 w1, w2; w1.x = cvt_pk_bf16(y1a[0], y1a[1]); w1.y = cvt_pk_bf16(y1a[2], y1a[3]); w1.z = cvt_pk_bf16(y1b[0], y1b[1]); w1.w = cvt_pk_bf16(y1b[2], y1b[3]);
    w2.x = cvt_pk_bf16(y2a[0], y2a[1]); w2.y = cvt_pk_bf16(y2a[2], y2a[3]); w2.z = cvt_pk_bf16(y2b[0], y2b[1]); w2.w = cvt_pk_bf16(y2b[2], y2b[3]);
    *(u32x4*)rp = w1; *(u32x4*)(rp + half) = w2;
}
__device__ __forceinline__ void st_rope(bf16_t* rp, int half, const f32x4 x1, const f32x4 x2, const f32x4 c, const f32x4 s) {
    const f32x4 y1 = x1 * c - x2 * s, y2 = x2 * c + x1 * s;
    u32x2 w1, w2; w1.x = cvt_pk_bf16(y1[0], y1[1]); w1.y = cvt_pk_bf16(y1[2], y1[3]); w2.x = cvt_pk_bf16(y2[0], y2[1]); w2.y = cvt_pk_bf16(y2[2], y2[3]);
    *(u32x2*)rp = w1; *(u32x2*)(rp + half) = w2;
}
struct EpiZ {
    EPI_NOKSTEP
    __device__ __forceinline__ void prefetch(float (&pr)[8], int p, int pm, int, int wr, int fr) const { if (p < 2) {
#pragma unroll
        for (int g = 0; g < 8; ++g) pr[g] = rstd[pm * 256 + wr * 64 + fr + (g >> 2) * 128 + (g & 3) * 16]; } }
    bf16_t *QA, *KA, *VA, *XR, *GG, *CQ, *CKV; float* KRP; float* ssq24; const float *rstd, *cos128, *sin128; bf16_t* ERAW; float* essq;
    __device__ __forceinline__ void operator()(EPI_ARGS) const {
        const int row0 = pm * 256 + wr * 64 + fr;
        if (p == 2) {
            const int col0 = pn * 256 + wc * 32 + 8 * fq;
#pragma unroll
            for (int ai = 0; ai < 2; ++ai)
#pragma unroll
                for (int m = 0; m < 4; ++m) {
                    const int row = row0 + ai * 128 + m * 16; float s = 0.f;
#pragma unroll
                    for (int bj = 0; bj < 2; ++bj) { const f32x4 v0 = acc[ai][bj][m][0], v1 = acc[ai][bj][m][1]; s += dot4(v0) + dot4(v1);
                        st_plain8(ERAW + (size_t)row * DM + col0 + bj * 128, v0, v1); }
                    s += __shfl_xor(s, 16); s += __shfl_xor(s, 32);
                    if (fq == 0) essq[(size_t)row * 64 + pn * 4 + wc] = s;
                }
        } else if (p == 1) {
            if (wc < 2) {
                const int dl = 16 * wc + 4 * fq;
#pragma unroll
                for (int ai = 0; ai < 2; ++ai)
#pragma unroll
                    for (int m = 0; m < 4; ++m) {
                        const int row = row0 + ai * 128 + m * 16; const float rs = pre[ai * 4 + m]; float* kp = KRP + ((size_t)pn * M + row) * 64 + dl;
                        *(f32x4*)kp = acc[ai][0][m][0] * rs; *(f32x4*)(kp + 32) = acc[ai][0][m][1] * rs;
                    }
            }
        } else if (pn < 8) {
            const int dl = 32 * (wc & 1) + 8 * fq, hh = 2 * pn + (wc >> 1);
            f32x4 cb[2][2], sb[2][2]; float rsb[2];
#define RZ_LOAD(g, buf) do { const int row_ = row0 + ((g) >> 2) * 128 + ((g) & 3) * 16; rsb[buf] = pre[g]; const float* cp_ = cos128 + (size_t)row_ * 64 + dl; const float* sp_ = sin128 + (size_t)row_ * 64 + dl; \
        cb[buf][0] = *(const f32x4*)cp_; cb[buf][1] = *(const f32x4*)(cp_ + 4); sb[buf][0] = *(const f32x4*)sp_; sb[buf][1] = *(const f32x4*)(sp_ + 4); } while (0)
            RZ_LOAD(0, 0);
#pragma unroll
            for (int g = 0; g < 8; ++g) {
                const int ai = g >> 2, m = g & 3, buf = g & 1;
                if (g + 1 < 8) RZ_LOAD(g + 1, buf ^ 1);
                asm volatile("" ::: "memory");
                const int row = row0 + ai * 128 + m * 16; const float rs = rsb[buf];
                bf16_t* rp = (hh < 12) ? QA + (size_t)row * 1536 + hh * 128 + dl : KA + (size_t)row * 512 + (hh - 12) * 128 + dl;
                st_rope8(rp, 64, acc[ai][0][m][0] * rs, acc[ai][1][m][0] * rs, acc[ai][0][m][1] * rs, acc[ai][1][m][1] * rs, cb[buf][0], cb[buf][1], sb[buf][0], sb[buf][1]);
                asm volatile("" ::: "memory");
            }
#undef RZ_LOAD
        } else {
            bf16_t* base; int pitch, ct, ssq0 = -1; bool gelu = false;
            if (pn < 10) { base = VA; pitch = 512; ct = pn - 8; }
            else if (pn < 14) { base = XR; pitch = 1024; ct = pn - 10; }
            else if (pn < 18) { base = GG; pitch = 1024; ct = pn - 14; gelu = true; }
            else if (pn < 22) { base = CQ; pitch = 1024; ct = pn - 18; ssq0 = (pn - 18) * 4 + wc; }
            else { base = CKV; pitch = 512; ct = pn - 22; ssq0 = 16 + (pn - 22) * 4 + wc; }
            const int col0 = ct * 256 + wc * 32 + 8 * fq;
            float rsa[8];
#pragma unroll
            for (int g = 0; g < 8; ++g) rsa[g] = pre[g];
#pragma unroll
            for (int ai = 0; ai < 2; ++ai)
#pragma unroll
                for (int m = 0; m < 4; ++m) {
                    const int row = row0 + ai * 128 + m * 16; const float rs = rsa[ai * 4 + m]; float s = 0.f;
#pragma unroll
                    for (int bj = 0; bj < 2; ++bj) {
                        f32x4 v0 = acc[ai][bj][m][0] * rs, v1 = acc[ai][bj][m][1] * rs;
                        if (gelu) {
#pragma unroll
                            for (int j = 0; j < 4; ++j) { v0[j] = gelu_tanh(v0[j]); v1[j] = gelu_tanh(v1[j]); }
                        }
                        s += dot4(v0) + dot4(v1);
                        st_plain8(base + (size_t)row * pitch + col0 + bj * 128, v0, v1);
                    }
                    if (ssq0 >= 0) { s += __shfl_xor(s, 16); s += __shfl_xor(s, 32); if (fq == 0) ssq24[(size_t)row * 24 + ssq0] = s; }
                }
        }
    }
};
struct EpiUp {
    EPI_NOPRE
    bf16_t *QN, *QR, *KVM; const float *ssq24, *cos64, *sin64;
    __device__ __forceinline__ void operator()(EPI_ARGS) const {
        const int row0 = pm * 256 + wr * 64 + fr;
        {
            float rs[2][4];
#pragma unroll
            for (int ai = 0; ai < 2; ++ai)
#pragma unroll
                for (int m = 0; m < 4; ++m) {
                    const float* sp = ssq24 + (size_t)(row0 + ai * 128 + m * 16) * 24; float s;
                    if (p == 0) { const f32x4 a = *(const f32x4*)sp, b = *(const f32x4*)(sp + 4), c = *(const f32x4*)(sp + 8), d = *(const f32x4*)(sp + 12);
                        s = ((a.x + a.y) + (a.z + a.w)) + ((b.x + b.y) + (b.z + b.w)) + ((c.x + c.y) + (c.z + c.w)) + ((d.x + d.y) + (d.z + d.w)); s *= (1.0f / QRANK); }
                    else { const f32x4 a = *(const f32x4*)(sp + 16), b = *(const f32x4*)(sp + 20); s = ((a.x + a.y) + (a.z + a.w)) + ((b.x + b.y) + (b.z + b.w)); s *= (1.0f / KVRANK); }
                    rs[ai][m] = 1.0f / sqrtf(s + EPS);
                }
            if (p == 0 && pn >= 6) {
                const int dl = 8 * fq, head = (pn - 6) * 4 + wc;
#pragma unroll
                for (int ai = 0; ai < 2; ++ai)
#pragma unroll
                    for (int m = 0; m < 4; ++m) {
                        const int row = row0 + ai * 128 + m * 16; const float r = rs[ai][m];
                        const float* cp_ = cos64 + (size_t)row * 32 + dl; const float* sp_ = sin64 + (size_t)row * 32 + dl;
                        st_rope8(QR + (size_t)row * 768 + head * 64 + dl, 32, acc[ai][0][m][0] * r, acc[ai][1][m][0] * r, acc[ai][0][m][1] * r, acc[ai][1][m][1] * r,
                                 *(const f32x4*)cp_, *(const f32x4*)(cp_ + 4), *(const f32x4*)sp_, *(const f32x4*)(sp_ + 4));
                    }
            } else {
                bf16_t* base = (p == 0) ? QN : KVM; const int pitch = (p == 0) ? 1536 : NKVU; const int col0 = pn * 256 + wc * 32 + 8 * fq;
#pragma unroll
                for (int ai = 0; ai < 2; ++ai)
#pragma unroll
                    for (int m = 0; m < 4; ++m) {
                        const int row = row0 + ai * 128 + m * 16; const float r = rs[ai][m];
#pragma unroll
                        for (int bj = 0; bj < 2; ++bj) st_plain8(base + (size_t)row * pitch + col0 + bj * 128, acc[ai][bj][m][0] * r, acc[ai][bj][m][1] * r);
                    }
            }
        }
    }
};
struct EpiGate {
    EPI_NOPRE
    const float *ba, *bx, *lam; const bf16_t* XC; float *AA, *BB;
    __device__ __forceinline__ void operator()(EPI_ARGS) const {
        const int row0 = pm * 256 + wr * 64 + fr;
        u32x2 xw[2][8];
#pragma unroll
        for (int bj = 0; bj < 2; ++bj)
#pragma unroll
            for (int g = 0; g < 8; ++g) xw[bj][g] = *(const u32x2*)(XC + (size_t)(row0 + (g >> 2) * 128 + (g & 3) * 16) * RGW + pn * 128 + bj * 64 + wc * 16 + 4 * fq);
#pragma unroll
        for (int bj = 0; bj < 2; ++bj) {
            const int ch = pn * 128 + bj * 64 + wc * 16 + 4 * fq;
            const f32x4 vba = *(const f32x4*)(ba + ch), vbx = *(const f32x4*)(bx + ch), c8 = *(const f32x4*)(lam + ch);
#pragma unroll
            for (int g = 0; g < 8; ++g) {
                const int ai = g >> 2, m = g & 3;
                const int row = row0 + ai * 128 + m * 16; const size_t off = (size_t)row * RGW + ch;
                const float xc[4] = {bflo(xw[bj][g].x), bfhi(xw[bj][g].x), bflo(xw[bj][g].y), bfhi(xw[bj][g].y)};
                const f32x4 ga = acc[ai][bj][m][0] + vba, gx = acc[ai][bj][m][1] + vbx; f32x4 av, bv;
#pragma unroll
                for (int j = 0; j < 4; ++j) {
                    const float r = sigmoidf_(ga[j]), ii = sigmoidf_(gx[j]), la = c8[j] * r;
                    const float x2 = 2.0f * la, av_ = __builtin_amdgcn_exp2f(1.4426950408889634f * la);
                    const float poly = -x2 * (1.0f + x2 * (0.5f + x2 * (0.16666667f + x2 * (0.041666668f + x2 * 0.008333334f))));
                    const float em = x2 > -0.25f ? poly : 1.0f - av_ * av_;
                    av[j] = av_; bv[j] = __builtin_amdgcn_sqrtf(em) * ii * xc[j];
                }
                *(f32x4*)(AA + off) = av; *(f32x4*)(BB + off) = bv;
            }
        }
    }
};

struct EpiMid {
    static constexpr bool AFTER_DRAIN = false;
    EpiUp up; EpiGate gate;
    __device__ __forceinline__ void operator()(EPI_ARGS) const { if (p > 0) up(acc, pre, p - 1, pm, pn, wr, wc, fr, fq); else gate(acc, pre, p, pm, pn, wr, wc, fr, fq); }
    EPI_NOPRE
};

namespace att {
constexpr int SHM_V = 64 * 128 * 2, SHM_K = 64 * 128 * 2, SHM_KR = 64 * 64 * 2;
constexpr int OFF_V = 0, OFF_K = 2 * SHM_V, OFF_KR = OFF_K + 2 * SHM_K, OFF_WS = OFF_KR + 2 * SHM_KR, OFF_UW = OFF_WS + 8 * 64 * 4, OFF_QR = OFF_UW + 64, ATT_LDS = OFF_QR + 8 * 4096;
static_assert(ATT_LDS <= RING_BYTES, "attention LDS");
constexpr float THR = 8.f;
#define KSWZ(row, colB) ((row) * 256 + ((colB) ^ (((row) & 7) << 4)))
#define KRSWZ(row, colB) ((row) * 128 + ((colB) ^ (((row) & 7) << 4)))
#define SBAR() __builtin_amdgcn_sched_barrier(0)
__device__ __forceinline__ int v_st(int k, int c) { const int kk = (k & ~0xC) | ((k & 4) << 1) | ((k & 8) >> 1); return ((kk >> 3) * 4 + (c >> 5)) * 512 + ((kk & 7) * 32 + (c & 31)) * 2; }
__device__ __forceinline__ int v_rd_base(int lane) { return ((lane & 3) << 3) | (((lane >> 2) & 3) << 6) | (((lane >> 4) & 1) << 5) | (((lane >> 5) & 1) << 8); }
constexpr int v_rd_off(int d0, int ks, int half) { return d0 * 512 + ks * 4096 + half * 2048; }
__device__ __forceinline__ int crow(int r, int hi) { return (r & 3) + 8 * (r >> 2) + 4 * hi; }
__device__ __forceinline__ void mask_tile(f32x16& p0, f32x16& p1, int dq, unsigned W) {
    const float NEG = -__builtin_inff();
#pragma unroll
    for (int r = 0; r < 16; ++r) {
        const int c = (r & 3) + 8 * (r >> 2);
        if ((unsigned)(dq - c) >= W) p0[r] = NEG;
        if ((unsigned)(dq - c - 32) >= W) p1[r] = NEG;
    }
}
__device__ __forceinline__ void partialSM(f32x16& p0, f32x16& p1, float& m_reg, float& alpha, float scale, float c2) {
    float pmax = p0[0];
#pragma unroll
    for (int r = 1; r < 16; ++r) pmax = fmaxf(pmax, p0[r]);
#pragma unroll
    for (int r = 0; r < 16; ++r) pmax = fmaxf(pmax, p1[r]);
    { auto rr = __builtin_amdgcn_permlane32_swap(__float_as_uint(pmax), __float_as_uint(pmax), false, false);
      pmax = fmaxf(__uint_as_float(rr[0]), __uint_as_float(rr[1])); }
    float mn;
    if (__builtin_expect(__all((pmax - m_reg) * scale <= THR), 1)) { mn = m_reg; alpha = 1.f; }
    else { mn = fmaxf(m_reg, pmax); alpha = __builtin_amdgcn_exp2f((m_reg - mn) * c2); m_reg = mn; }
    const float mnL = -mn * c2;
#pragma unroll
    for (int r = 0; r < 16; ++r) p0[r] = __builtin_amdgcn_exp2f(fmaf(p0[r], c2, mnL));
#pragma unroll
    for (int r = 0; r < 16; ++r) p1[r] = __builtin_amdgcn_exp2f(fmaf(p1[r], c2, mnL));
}
__device__ __forceinline__ void finishSM(f32x16& p0, f32x16& p1, float alpha, float& l_reg, bf16x8& pa0, bf16x8& pa1, bf16x8& pa2, bf16x8& pa3) {
    float ps = 0;
#pragma unroll
    for (int r = 0; r < 16; ++r) ps += p0[r];
#pragma unroll
    for (int r = 0; r < 16; ++r) ps += p1[r];
    { auto rr = __builtin_amdgcn_permlane32_swap(__float_as_uint(ps), __float_as_uint(ps), false, false);
      ps = __uint_as_float(rr[0]) + __uint_as_float(rr[1]); }
    l_reg = l_reg * alpha + ps;
#define PK4(P, B_, OUT) do { unsigned a0 = cvt_pk_bf16(P[B_+0], P[B_+1]), a1 = cvt_pk_bf16(P[B_+2], P[B_+3]);                          \
        unsigned b0 = cvt_pk_bf16(P[B_+4], P[B_+5]), b1 = cvt_pk_bf16(P[B_+6], P[B_+7]);                                             \
        auto r0 = __builtin_amdgcn_permlane32_swap(a0, b0, false, false); auto r1 = __builtin_amdgcn_permlane32_swap(a1, b1, false, false); \
        u32x4 w = {r0[0], r1[0], r0[1], r1[1]}; OUT = __builtin_bit_cast(bf16x8, w); } while (0)
    PK4(p0, 0, pa0); PK4(p0, 8, pa1); PK4(p1, 0, pa2); PK4(p1, 8, pa3);
#undef PK4
}
template <int KB, bool MLA>
__device__ __forceinline__ void qkt(f32x16& p0, f32x16& p1, const LAS char* K_lds, const LAS char* KR_lds, int r32, int hi, const bf16x8* qr, const LAS char* qrl, bool act) {
    if (!act) { const float NEG = -__builtin_inff();
#pragma unroll
        for (int r = 0; r < 16; ++r) { p0[r] = NEG; p1[r] = NEG; } return; }
#pragma unroll
    for (int r = 0; r < 16; ++r) { p0[r] = 0.f; p1[r] = 0.f; }
    const LAS char* kb[4];
#pragma unroll
    for (int dd = 0; dd < 4; ++dd) kb[dd] = K_lds + KB * SHM_K + KSWZ(r32, (dd * 16 + hi * 8) * 2);
#pragma unroll
    for (int d0 = 0; d0 < 8; ++d0) { const LAS char* a = kb[d0 & 3] + (d0 >> 2) * 128;
        const bf16x8 b0 = *(const LAS bf16x8*)a;
        const bf16x8 b1 = *(const LAS bf16x8*)(a + 32 * 256);
        p0 = __builtin_amdgcn_mfma_f32_32x32x16_bf16(b0, qr[d0], p0, 0, 0, 0);
        p1 = __builtin_amdgcn_mfma_f32_32x32x16_bf16(b1, qr[d0], p1, 0, 0, 0); }
    if (MLA) {
#pragma unroll
        for (int d0 = 0; d0 < 4; ++d0) { const LAS char* a = KR_lds + KB * SHM_KR + KRSWZ(r32, (d0 * 16 + hi * 8) * 2);
            const bf16x8 b0 = *(const LAS bf16x8*)a;
            const bf16x8 b1 = *(const LAS bf16x8*)(a + 32 * 128);
            const bf16x8 qf = *(const LAS bf16x8*)(qrl + KRSWZ(r32, (d0 * 16 + hi * 8) * 2));
            p0 = __builtin_amdgcn_mfma_f32_32x32x16_bf16(b0, qf, p0, 0, 0, 0);
            p1 = __builtin_amdgcn_mfma_f32_32x32x16_bf16(b1, qf, p1, 0, 0, 0); }
    }
}
template <int VB>
__device__ __forceinline__ void pv_tile(f32x16* o, int vb0, bf16x8 pa0, bf16x8 pa1, bf16x8 pa2, bf16x8 pa3, bool act) {
    if (!act) return;
#define TRRD(dst, off) asm volatile("ds_read_b64_tr_b16 %0, %1 offset:%2" : "=&v"(dst) : "v"(vb0), "i"(off) : "memory")
#define PV_D0(d0) do { s16x4 l0, l1, l2, l3, h0, h1, h2, h3; constexpr int b_ = VB * SHM_V + v_rd_off(d0, 0, 0); \
        TRRD(l0, b_); TRRD(h0, b_ + 2048); TRRD(l1, b_ + 4096); TRRD(h1, b_ + 6144); TRRD(l2, b_ + 8192); TRRD(h2, b_ + 10240); TRRD(l3, b_ + 12288); TRRD(h3, b_ + 14336); \
        asm volatile("s_waitcnt lgkmcnt(0)" ::: "memory"); SBAR(); \
        o[d0] = __builtin_amdgcn_mfma_f32_32x32x16_bf16(pa0, (bf16x8){l0[0], l0[1], l0[2], l0[3], h0[0], h0[1], h0[2], h0[3]}, o[d0], 0, 0, 0);   \
        o[d0] = __builtin_amdgcn_mfma_f32_32x32x16_bf16(pa1, (bf16x8){l1[0], l1[1], l1[2], l1[3], h1[0], h1[1], h1[2], h1[3]}, o[d0], 0, 0, 0);   \
        o[d0] = __builtin_amdgcn_mfma_f32_32x32x16_bf16(pa2, (bf16x8){l2[0], l2[1], l2[2], l2[3], h2[0], h2[1], h2[2], h2[3]}, o[d0], 0, 0, 0);   \
        o[d0] = __builtin_amdgcn_mfma_f32_32x32x16_bf16(pa3, (bf16x8){l3[0], l3[1], l3[2], l3[3], h3[0], h3[1], h3[2], h3[3]}, o[d0], 0, 0, 0); } while (0)
    PV_D0(0); PV_D0(1); PV_D0(2); PV_D0(3);
#undef PV_D0
#undef TRRD
}
struct Tens { const bf16_t* Q; const bf16_t* QR; const bf16_t* K; const bf16_t* V; const bf16_t* KR; bf16_t* O; float* SS; int qp, qrp, kp, vp, op; };
template <bool MLA>
__device__ __forceinline__ void attn_unit(LAS char* L, int wv, unsigned lbase, const Tens& T, int q0, int W, float m0, float l0, float scale) {
    const int tid = otid(wv), wid = __builtin_amdgcn_readfirstlane(tid >> 6), lane = tid & 63, r32 = lane & 31, hi = lane >> 5;
    const float c2 = 1.4426950408889634f * scale;
    const int lowk = q0 - W + 1, j_lo = lowk > 0 ? lowk / 64 : 0, j_hi = q0 / 64 + 4, NT = j_hi - j_lo;
    const int qlo = q0 + wid * 32, qm = qlo + r32 - 4 * hi;
    LAS char* V_lds = L + OFF_V; LAS char* K_lds = L + OFF_K; LAS char* KR_lds = L + OFF_KR;
    LAS float* ws = (LAS float*)(L + OFF_WS) + wid * 64; LAS float* li_l = ws; LAS float* al_l = ws + 32;
    float m_reg = m0, l_reg = l0; f32x16 o[4];
#pragma unroll
    for (int d = 0; d < 4; ++d)
#pragma unroll
        for (int r = 0; r < 16; ++r) o[d][r] = 0.f;
    const int sr = tid >> 4, sc = (tid & 15) * 8, vst0 = v_st(sr, sc), vst1 = v_st(32 + sr, sc), kws = KSWZ(sr, sc * 2);
    const int krr = tid >> 3, krc = (tid & 7) * 8, krws = KRSWZ(krr, krc * 2);
    const int vb0 = (int)lbase + OFF_V + v_rd_base(lane);
    bf16x8 qr[8]; LAS char* qrl = L + OFF_QR + wid * 4096;
#pragma unroll
    for (int d0 = 0; d0 < 8; ++d0) qr[d0] = *(const bf16x8*)(T.Q + (size_t)(wid * 32 + r32) * T.qp + d0 * 16 + hi * 8);
    if (MLA) {
#pragma unroll
        for (int d0 = 0; d0 < 4; ++d0) *(LAS bf16x8*)(qrl + KRSWZ(r32, (d0 * 16 + hi * 8) * 2)) = *(const bf16x8*)(T.QR + (size_t)(wid * 32 + r32) * T.qrp + d0 * 16 + hi * 8);
    }
    bf16x8 st_k0, st_k1, st_v0, st_v1, st_kr;
#define SLOAD(k0) do { st_v0 = *(const bf16x8*)(T.V + (size_t)((k0) + sr) * T.vp + sc); st_v1 = *(const bf16x8*)(T.V + (size_t)((k0) + 32 + sr) * T.vp + sc); \
                       st_k0 = *(const bf16x8*)(T.K + (size_t)((k0) + sr) * T.kp + sc); st_k1 = *(const bf16x8*)(T.K + (size_t)((k0) + 32 + sr) * T.kp + sc); \
                       if (MLA) st_kr = *(const bf16x8*)(T.KR + (size_t)((k0) + krr) * 64 + krc); } while (0)
#define SWRITE(bf) do { *(LAS bf16x8*)(V_lds + (bf) * SHM_V + vst0) = st_v0; *(LAS bf16x8*)(V_lds + (bf) * SHM_V + vst1) = st_v1; \
                        *(LAS bf16x8*)(K_lds + (bf) * SHM_K + kws) = st_k0; *(LAS bf16x8*)(K_lds + (bf) * SHM_K + kws + 32 * 256) = st_k1; \
                        if (MLA) *(LAS bf16x8*)(KR_lds + (bf) * SHM_KR + krws) = st_kr; } while (0)
#define KBASE(t) ((j_lo + (t)) * 64)
#define ACT(t) (KBASE(t) <= qlo + 31 && KBASE(t) + 63 >= qlo - W + 1)
#define STEP(BUF, t) do { \
        if ((t) + 1 < NT) SLOAD(KBASE((t) + 1)); \
        SBAR(); const bool act_ = ACT(t); \
        qkt<BUF, MLA>(p0, p1, K_lds, KR_lds, r32, hi, qr, qrl, act_); \
        { const int kb_ = KBASE(t); if (act_ && (kb_ + 63 > qlo || kb_ <= qlo + 31 - W)) mask_tile(p0, p1, qm - kb_, (unsigned)W); } \
        partialSM(p0, p1, m_reg, alpha, scale, c2); \
        if (__any(alpha < 1.f)) { if (hi == 0) al_l[r32] = alpha; LDS_WAIT(); \
            _Pragma("unroll") for (int d_ = 0; d_ < 4; ++d_) _Pragma("unroll") for (int r = 0; r < 16; ++r) o[d_][r] *= al_l[crow(r, hi)]; } \
        finishSM(p0, p1, alpha, l_reg, pa0, pa1, pa2, pa3); SBAR(); \
        pv_tile<BUF>(o, vb0, pa0, pa1, pa2, pa3, act_); \
        if ((t) + 1 < NT) { VM_WAIT(); SWRITE((BUF) ^ 1); } \
        __syncthreads(); } while (0)
    f32x16 p0, p1; float alpha; bf16x8 pa0, pa1, pa2, pa3;
    SLOAD(KBASE(0)); VM_WAIT(); SWRITE(0); __syncthreads();
    for (int t = 0; t < NT; t += 2) {
        STEP(0, t);
        if (t + 1 < NT) STEP(1, t + 1);
    }
    if (hi == 0) li_l[r32] = l_reg;
    LDS_WAIT();
    bf16_t* Ow = T.O + (size_t)(wid * 32) * T.op;
    float sq[16];
#pragma unroll
    for (int r = 0; r < 16; ++r) { const int orow = crow(r, hi); const float rl = __builtin_amdgcn_rcpf(li_l[orow]); float s = 0.f;
#pragma unroll
        for (int d0 = 0; d0 < 4; ++d0) { const float v = o[d0][r] * rl; const float vn = __shfl_xor(v, 1); s += v * v;
            if ((r32 & 1) == 0) *(unsigned*)(Ow + (size_t)orow * T.op + d0 * 32 + r32) = cvt_pk_bf16(v, vn); }
        sq[r] = s; }
    rs_step<8>(sq, (lane & 16) != 0, 16); rs_step<4>(sq, (lane & 8) != 0, 8); rs_step<2>(sq, (lane & 4) != 0, 4); rs_step<1>(sq, (lane & 2) != 0, 2);
    { const float tot = sq[0] + __shfl_xor(sq[0], 1); if ((r32 & 1) == 0) T.SS[(size_t)(wid * 32 + crow(r32 >> 1, hi)) * 40] = tot; }
    __syncthreads();
#undef SLOAD
#undef SWRITE
#undef KBASE
#undef ACT
#undef STEP
}
}

struct Args { const void* in[NIN]; float* out; unsigned char* ws; int ph_lo, ph_hi; float inv128[64]; float inv64[32]; };
struct Frame {
    LAS unsigned char* lds; unsigned* ctl; unsigned char* ws;
    int tid, lane, wave, vcu, G, gw, NGW;
    __device__ __forceinline__ void relane() { tid = otid(wave); lane = tid & 63; wave = __builtin_amdgcn_readfirstlane(tid >> 6); gw = vcu * 8 + wave; ws = oweak(ws); }
};
enum { I_X = 0, I_P, I_POS, I_PREMIX, I_WIN, I_SINK, I_CONVW, I_CONVB, I_GAW, I_GAB, I_GXW, I_GXB, I_LAM, I_QNORM, I_WUQ, I_KVNORM, I_WUKV, I_GNORM, I_WOUT, I_POSTMIX, I_PREFFN,
       I_WGATE, I_WUP, I_WDOWN, I_POSTFFN, I_WPLE, I_PLENORM, I_WPG, I_BPG };

struct TJob { const float* s0; long sd; const float* gain; bf16_t* dst; int K, ld, kind, nb; };
__device__ __forceinline__ const float* tj_col(const TJob& J, int np) {
    const int pn = np >> 8, r = np & 255, bj = r >> 7, wc = (r >> 5) & 3, n = (r >> 4) & 1, fq = (r >> 2) & 3;
    const int p8 = bj * 128 + wc * 32 + fq * 8 + n * 4;
    switch (J.kind) {
        case 1: if (pn < 8) return J.s0 + (2 * pn + (wc >> 1)) * 128 + 32 * (wc & 1) + 8 * fq + 4 * bj + 64 * n;
                if (pn < 24) return J.s0 + pn * 256 + p8;
                return nullptr;
        case 6: return (bj == 0 && wc < 2) ? J.s0 + (size_t)(512 * pn) * J.ld + 6144 + 16 * wc + 4 * fq + 32 * n : nullptr;
        case 2: if (pn < 6) { const int Lc = pn * 256 + p8; return J.s0 + (Lc >> 7) * 192 + (Lc & 127); }
                return J.s0 + ((pn - 6) * 4 + wc) * 192 + 128 + 8 * fq + 4 * bj + 32 * n;
        case 3: return J.s0 + pn * 256 + p8;
        case 4: return J.s0 + (long)n * J.sd + pn * (128 * 128) + 64 * bj + 16 * wc + 4 * fq;
        case 5: return J.s0 + (long)n * J.sd + pn * 128 + wc * 32 + fq * 8 + bj * 4;
        default: return J.s0 + pn * 256 + p8;
    }
}
__device__ __forceinline__ void tr_item(const TJob& J, int kb, int nb, LAS unsigned* T, int lane) {
    const int n4 = lane & 15, kq = lane >> 4, k0 = kb * 64;
    const float* cp = tj_col(J, nb * 64 + n4 * 4);
    f32x4 v0[8], v1[8];
#pragma unroll
    for (int i = 0; i < 8; ++i) { const int k = k0 + 8 * i + 2 * kq;
        if (cp) { v0[i] = __builtin_nontemporal_load((const f32x4*)(cp + (size_t)k * J.ld)); v1[i] = __builtin_nontemporal_load((const f32x4*)(cp + (size_t)(k + 1) * J.ld)); } else { v0[i] = (f32x4){0.f, 0.f, 0.f, 0.f}; v1[i] = v0[i]; } }
    const float* gp = J.gain; if (gp && J.kind == 6) gp += 512 * ((nb * 64) >> 8);
#pragma unroll
    for (int i = 0; i < 8; ++i) { const int k = k0 + 8 * i + 2 * kq; float g0 = 1.f, g1 = 1.f; if (gp) { g0 = gp[k]; g1 = gp[k + 1]; }
#pragma unroll
        for (int jj = 0; jj < 4; ++jj) T[(n4 * 4 + jj) * 32 + ((i ^ (n4 & 7)) * 4 + kq)] = cvt_pk_bf16(v0[i][jj] * g0, v1[i][jj] * g1); }
    LDS_WAIT(); asm volatile("" ::: "memory");
#pragma unroll
    for (int ps = 0; ps < 8; ++ps) { const int row = ps * 8 + (lane >> 3), c = lane & 7;
        const u32x4 w = *(const LAS u32x4*)(T + row * 32 + ((c ^ ((row >> 2) & 7)) * 4));
        __builtin_nontemporal_store(w, (u32x4*)(J.dst + (size_t)(nb * 64 + row) * J.K + k0 + 8 * c)); }
    LDS_WAIT(); asm volatile("" ::: "memory");
}
constexpr int TI_Z = 64 * 96, TI_KR = 8 * 32, TI_UQ = 16 * 36, TI_UKV = 8 * 48, TI_RG = 2 * 32, TI_OUT = 64 * 64, TI_GU = 64 * 344, TI_DN = 172 * 64, TI_PLE = 4 * 64, TI_PG = 64 * 64;
constexpr int TI_LAYER = TI_Z + TI_KR + TI_UQ + TI_UKV + TI_RG + TI_OUT + TI_GU + TI_DN + TI_PLE + TI_PG;
constexpr int TI_EARLY = TI_Z + TI_KR + TI_UQ + TI_UKV + TI_RG + TI_PLE;
__device__ __forceinline__ void convert_items(const Frame& F, const Args& a, int it0, int it1, int gw = -1, int ngw = 0) {
    LAS unsigned* T = (LAS unsigned*)(F.lds + F.wave * 8192);
    if (gw < 0) { gw = F.gw; ngw = F.NGW; }
    for (int it = it0 + gw; it < it1; it += ngw) {
        const int l = it / TI_LAYER; int r = it % TI_LAYER;
        unsigned char* wl = F.ws + WS_W + (size_t)l * W_LAYER; TJob J; J.sd = 0; J.gain = nullptr;
        if (r < TI_Z) { J.s0 = (const float*)a.in[I_WIN] + (size_t)l * DM * NZ; J.gain = (const float*)a.in[I_PREMIX] + l * DM; J.dst = (bf16_t*)(wl + WO_Z); J.K = DM; J.ld = NZ; J.kind = 1; J.nb = 96; }
        else if ((r -= TI_Z) < TI_KR) { J.s0 = (const float*)a.in[I_WIN] + (size_t)l * DM * NZ; J.gain = (const float*)a.in[I_PREMIX] + l * DM; J.dst = (bf16_t*)(wl + WO_KR); J.K = 512; J.ld = NZ; J.kind = 6; J.nb = 32; }
        else if ((r -= TI_KR) < TI_UQ) { J.s0 = (const float*)a.in[I_WUQ] + (size_t)l * QRANK * NQU; J.gain = (const float*)a.in[I_QNORM] + l * QRANK; J.dst = (bf16_t*)(wl + WO_UQ); J.K = QRANK; J.ld = NQU; J.kind = 2; J.nb = 36; }
        else if ((r -= TI_UQ) < TI_UKV) { J.s0 = (const float*)a.in[I_WUKV] + (size_t)l * KVRANK * NKVU; J.gain = (const float*)a.in[I_KVNORM] + l * KVRANK; J.dst = (bf16_t*)(wl + WO_UKV); J.K = KVRANK; J.ld = NKVU; J.kind = 3; J.nb = 48; }
        else if ((r -= TI_UKV) < TI_RG) { J.s0 = (const float*)a.in[I_GAW] + (size_t)l * 8 * 128 * 128; J.sd = (const float*)a.in[I_GXW] - (const float*)a.in[I_GAW]; J.dst = (bf16_t*)(wl + WO_RG); J.K = 128; J.ld = 128; J.kind = 4; J.nb = 32; }
        else if ((r -= TI_RG) < TI_PLE) { J.s0 = (const float*)a.in[I_WPLE] + (size_t)l * PLE * DM; J.dst = (bf16_t*)(wl + WO_PLE); J.K = PLE; J.ld = DM; J.kind = 0; J.nb = 64; }
        else if ((r -= TI_PLE) < TI_OUT) { J.s0 = (const float*)a.in[I_WOUT] + (size_t)l * DM * DM; J.gain = (const float*)a.in[I_GNORM] + l * DM; J.dst = (bf16_t*)(wl + WO_OUT); J.K = DM; J.ld = DM; J.kind = 0; J.nb = 64; }
        else if ((r -= TI_OUT) < TI_GU) { J.s0 = (const float*)a.in[I_WGATE] + (size_t)l * DM * DFF; J.sd = (const float*)a.in[I_WUP] - (const float*)a.in[I_WGATE]; J.gain = (const float*)a.in[I_PREFFN] + l * DM; J.dst = (bf16_t*)(wl + WO_GU); J.K = DM; J.ld = DFF; J.kind = 5; J.nb = 344; }
        else if ((r -= TI_GU) < TI_DN) { J.s0 = (const float*)a.in[I_WDOWN] + (size_t)l * DFF * DM; J.dst = (bf16_t*)(wl + WO_DN); J.K = DFF; J.ld = DM; J.kind = 0; J.nb = 64; }
        else { r -= TI_DN; J.s0 = (const float*)a.in[I_WPG] + (size_t)l * DM * DM; J.dst = (bf16_t*)(wl + WO_PG); J.K = DM; J.ld = DM; J.kind = 0; J.nb = 64; }
        tr_item(J, r / J.nb, r % J.nb, T, F.lane);
    }
}
__device__ __forceinline__ void prologue(const Frame& F, const Args& a) {
    convert_items(F, a, 0, TI_EARLY);
    const int gt = F.vcu * 512 + F.tid, NGT = F.G * 512;
    const int* pos = (const int*)a.in[I_POS];
    float* c128 = (float*)(F.ws + WS_COS128); float* s128 = (float*)(F.ws + WS_SIN128); float* c64 = (float*)(F.ws + WS_COS64); float* s64 = (float*)(F.ws + WS_SIN64);
    for (int i0 = gt; i0 < M * 96; i0 += 6 * NGT) {
        int pr[6];
#pragma unroll
        for (int u = 0; u < 6; ++u) { const int i = i0 + u * NGT; pr[u] = i < M * 96 ? pos[i / 96] : 0; }
#pragma unroll
        for (int u = 0; u < 6; ++u) { const int i = i0 + u * NGT; if (i < M * 96) {
            const int row = i / 96, k = i % 96; const float inv = k < 64 ? a.inv128[k] : a.inv64[k - 64];
            const float ang = (float)pr[u] * inv; double rev = (double)ang * 0.15915494309189535; rev -= rint(rev); const float fr = (float)rev;
            const float c = __builtin_amdgcn_cosf(fr), s = __builtin_amdgcn_sinf(fr);
            if (k < 64) { c128[(size_t)row * 64 + k] = c; s128[(size_t)row * 64 + k] = s; } else { c64[(size_t)row * 32 + k - 64] = c; s64[(size_t)row * 32 + k - 64] = s; } } }
    }
    { const float* lam = (const float*)a.in[I_LAM]; float* c8 = (float*)(F.ws + WS_C8);
      for (int i = gt; i < DEPTH * RGW; i += NGT) c8[i] = -8.0f * log1pf(expf(-lam[i])); }
    { const f32x4* ps = (const f32x4*)a.in[I_P]; u32x2* pd = (u32x2*)(F.ws + WS_PB);
      for (int i0 = gt; i0 < DEPTH * M * PLE / 4; i0 += 8 * NGT) {
          f32x4 v[8];
#pragma unroll
          for (int u = 0; u < 8; ++u) { const int i = i0 + u * NGT; v[u] = i < DEPTH * M * PLE / 4 ? __builtin_nontemporal_load(ps + i) : (f32x4){0.f, 0.f, 0.f, 0.f}; }
#pragma unroll
          for (int u = 0; u < 8; ++u) { const int i = i0 + u * NGT; if (i < DEPTH * M * PLE / 4) { u32x2 w; w.x = cvt_pk_bf16(v[u].x, v[u].y); w.y = cvt_pk_bf16(v[u].z, v[u].w); pd[i] = w; } } } }
    { const float* x = (const float*)a.in[I_X]; bf16_t* XB = (bf16_t*)(F.ws + WS_XB); float* rstd = (float*)(F.ws + WS_RSTD);
      for (int m0 = F.gw; m0 < M; m0 += 2 * F.NGW) {
          const int m1 = m0 + F.NGW; const bool has1 = m1 < M;
          const f32x4* xr0 = (const f32x4*)(x + (size_t)m0 * DM) + F.lane; const f32x4* xr1 = (const f32x4*)(x + (size_t)(has1 ? m1 : m0) * DM) + F.lane;
          f32x4 v0[16], v1[16];
#pragma unroll
          for (int j = 0; j < 16; ++j) { v0[j] = __builtin_nontemporal_load(xr0 + 64 * j); v1[j] = __builtin_nontemporal_load(xr1 + 64 * j); }
#pragma unroll
          for (int rr = 0; rr < 2; ++rr) {
              if (rr == 1 && !has1) break;
              const int m = rr ? m1 : m0; u32x2* o = (u32x2*)(XB + (size_t)m * DM) + F.lane; float s = 0.f;
#pragma unroll
              for (int j = 0; j < 16; ++j) { const f32x4 v = rr ? v1[j] : v0[j]; s += dot4(v); u32x2 w; w.x = cvt_pk_bf16(v.x, v.y); w.y = cvt_pk_bf16(v.z, v.w); o[64 * j] = w; }
              s = wave_sum(s); if (F.lane == 0) rstd[m] = 1.0f / sqrtf(s * (1.0f / DM) + EPS);
          }
      } }
}
__device__ __forceinline__ void kr_finish(const Frame& F, const float* KRP, const float* c64, const float* s64, bf16_t* KR) {
    const int gt = F.vcu * 512 + F.tid, NGT = F.G * 512;
    for (int it = gt; it < M * 8; it += NGT) {
        const int row = it >> 3, d = (it & 7) * 4; f32x4 x1 = {0.f, 0.f, 0.f, 0.f}, x2 = x1;
#pragma unroll
        for (int sl = 0; sl < 8; ++sl) { const float* kp = KRP + ((size_t)sl * M + row) * 64 + d; x1 += *(const f32x4*)kp; x2 += *(const f32x4*)(kp + 32); }
        const f32x4 c = *(const f32x4*)(c64 + (size_t)row * 32 + d), sn = *(const f32x4*)(s64 + (size_t)row * 32 + d);
        st_rope(KR + (size_t)row * 64 + d, 32, x1, x2, c, sn);
    }
}
__device__ __forceinline__ void conv_tile(int tid, int pm, int blk, const bf16_t* XR, const float* cw, const float* cb, bf16_t* XC) {
    const int cg = blk * 128 + (tid & 15) * 8;
    const f32x4 b0 = *(const f32x4*)(cb + cg), b1 = *(const f32x4*)(cb + cg + 4);
    f32x4 w0[4], w1[4];
#pragma unroll
    for (int w = 0; w < 4; ++w) { w0[w] = *(const f32x4*)(cw + w * RGW + cg); w1[w] = *(const f32x4*)(cw + w * RGW + cg + 4); }
#pragma unroll
    for (int jh = 0; jh < 2; ++jh) {
        u32x4 xv[4][4];
#pragma unroll
        for (int jj = 0; jj < 4; ++jj) { const int row = pm * 256 + (jh * 4 + jj) * 32 + (tid >> 4), sq = row & (SEQ - 1);
#pragma unroll
            for (int w = 0; w < 4; ++w) xv[jj][w] = (sq - 3 + w >= 0) ? *(const u32x4*)(XR + (size_t)(row - 3 + w) * RGW + cg) : (u32x4){0u, 0u, 0u, 0u}; }
#pragma unroll
        for (int jj = 0; jj < 4; ++jj) { const int row = pm * 256 + (jh * 4 + jj) * 32 + (tid >> 4);
            f32x4 a0 = b0, a1 = b1;
#pragma unroll
            for (int w = 0; w < 4; ++w) {
                a0.x += w0[w].x * bflo(xv[jj][w].x); a0.y += w0[w].y * bfhi(xv[jj][w].x); a0.z += w0[w].z * bflo(xv[jj][w].y); a0.w += w0[w].w * bfhi(xv[jj][w].y);
                a1.x += w1[w].x * bflo(xv[jj][w].z); a1.y += w1[w].y * bfhi(xv[jj][w].z); a1.z += w1[w].z * bflo(xv[jj][w].w); a1.w += w1[w].w * bfhi(xv[jj][w].w);
            }
            u32x4 o; o.x = cvt_pk_bf16(a0.x, a0.y); o.y = cvt_pk_bf16(a0.z, a0.w); o.z = cvt_pk_bf16(a1.x, a1.y); o.w = cvt_pk_bf16(a1.z, a1.w);
            *(u32x4*)(XC + (size_t)row * RGW + cg) = o; }
    }
}
__device__ __forceinline__ void scan_pass1(const Frame& F, const float* AA, const float* BB, float* CP, float* CL) {
    const int gt = F.vcu * 512 + F.tid, NGT = F.G * 512;
    for (int it = gt; it < NB * 32 * RGW; it += NGT) {
        const int ch = it & (RGW - 1), ck = (it >> 10) & 31, b = it >> 15; const size_t base = (size_t)(b * SEQ + ck * 64) * RGW + ch;
        float P = 1.f, Lh = 0.f;
#pragma unroll
        for (int t0 = 0; t0 < 64; t0 += 32) {
            float av[32], bv[32];
#pragma unroll
            for (int t = 0; t < 32; ++t) { av[t] = AA[base + (size_t)(t0 + t) * RGW]; bv[t] = BB[base + (size_t)(t0 + t) * RGW]; }
#pragma unroll
            for (int t = 0; t < 32; ++t) { Lh = av[t] * Lh + bv[t]; P *= av[t]; }
        }
        CP[it] = P; CL[it] = Lh;
    }
}
__device__ __forceinline__ void scan_pass1_tile(int tid, int pm, int blk, const float* AA, const float* BB, float* CP, float* CL) {
    const int ch = blk * 128 + (tid & 127), row0 = pm * 256 + (tid >> 7) * 64, b = row0 >> 11, ck = (row0 & (SEQ - 1)) >> 6; const size_t base = (size_t)row0 * RGW + ch;
    float P = 1.f, Lh = 0.f;
#pragma unroll
    for (int t0 = 0; t0 < 64; t0 += 32) {
        float av[32], bv[32];
#pragma unroll
        for (int t = 0; t < 32; ++t) { av[t] = AA[base + (size_t)(t0 + t) * RGW]; bv[t] = BB[base + (size_t)(t0 + t) * RGW]; }
#pragma unroll
        for (int t = 0; t < 32; ++t) { Lh = av[t] * Lh + bv[t]; P *= av[t]; }
    }
    const int it = (b * 32 + ck) * RGW + ch; CP[it] = P; CL[it] = Lh;
}
__device__ __forceinline__ void scan_pass2(const Frame& F, const float* AA, const float* BB, const float* CP, const float* CL, const bf16_t* GG, bf16_t* OC, float* GSS) {
    const int gt = F.vcu * 512 + F.tid, NGT = F.G * 512;
    for (int it = gt; it < NB * 32 * RGW; it += NGT) {
        const int ch = it & (RGW - 1), ck = (it >> 10) & 31, b = it >> 15; const size_t row0 = (size_t)(b * SEQ + ck * 64);
        float h = 0.f;
        { float cp[32], cl[32];
#pragma unroll
          for (int cc = 0; cc < 32; ++cc) { const int j = (b * 32 + cc) * RGW + ch; cp[cc] = CP[j]; cl[cc] = CL[j]; }
#pragma unroll
          for (int cc = 0; cc < 32; ++cc) if (cc < ck) h = cp[cc] * h + cl[cc]; }
        for (int t0 = 0; t0 < 64; t0 += 32) {
            float av[32], bv[32]; unsigned short gv[32];
#pragma unroll
            for (int t = 0; t < 32; ++t) { const size_t r = row0 + t0 + t; av[t] = AA[r * RGW + ch]; bv[t] = BB[r * RGW + ch]; gv[t] = GG[r * RGW + ch]; }
#pragma unroll
            for (int t = 0; t < 32; ++t) { h = av[t] * h + bv[t]; const float ov = h * bf2f(gv[t]); OC[(row0 + t0 + t) * DM + 1536 + ch] = (bf16_t)(cvt_pk_bf16(ov, 0.f) & 0xffffu); av[t] = ov * ov; }
            rs_step<16>(av, (F.lane & 16) != 0, 16); rs_step<8>(av, (F.lane & 8) != 0, 8); rs_step<4>(av, (F.lane & 4) != 0, 4); rs_step<2>(av, (F.lane & 2) != 0, 2); rs_step<1>(av, (F.lane & 1) != 0, 1);
            { const float tot = av[0] + __shfl_xor(av[0], 32); if (F.lane < 32) GSS[(row0 + t0 + F.lane) * 40 + 12 + (ch >> 6)] = tot; }
        }
    }
}
__device__ __forceinline__ void groupnorm_phase(const Frame& F, const bf16_t* OC, bf16_t* MIX) {
    for (int m0 = F.gw; m0 < M; m0 += 2 * F.NGW) {
        const int m1 = m0 + F.NGW; const bool has1 = m1 < M;
        const u32x4* srcA = (const u32x4*)(OC + (size_t)m0 * DM) + F.lane; const u32x4* srcB = (const u32x4*)(OC + (size_t)(has1 ? m1 : m0) * DM) + F.lane;
        u32x4 va[8], vb[8];
#pragma unroll
        for (int j = 0; j < 8; ++j) { va[j] = srcA[64 * j]; vb[j] = srcB[64 * j]; }
#pragma unroll
        for (int rr = 0; rr < 2; ++rr) {
            if (rr == 1 && !has1) break;
            float s[8];
#pragma unroll
            for (int j = 0; j < 8; ++j) { const u32x4 v = rr ? vb[j] : va[j]; float t = 0.f;
#pragma unroll
                for (int e = 0; e < 4; ++e) { const float lo = bflo(v[e]), hi = bfhi(v[e]); t += lo * lo + hi * hi; }
                s[j] = t; }
            const float sa = wave_sum(s[0] + s[1] + s[2]), sb = wave_sum(s[3] + s[4]), sc = wave_sum(s[5] + s[6] + s[7]);
            const float ra = 1.0f / sqrtf(sa * (1.0f / 1536) + EPS), rb = 1.0f / sqrtf(sb * (1.0f / 1024) + EPS), rc = 1.0f / sqrtf(sc * (1.0f / 1536) + EPS);
            u32x4* dst = (u32x4*)(MIX + (size_t)(rr ? m1 : m0) * DM) + F.lane;
#pragma unroll
            for (int j = 0; j < 8; ++j) { const u32x4 v = rr ? vb[j] : va[j]; const float r = j < 3 ? ra : (j < 5 ? rb : rc); u32x4 w;
#pragma unroll
                for (int e = 0; e < 4; ++e) w[e] = cvt_pk_bf16(bflo(v[e]) * r, bfhi(v[e]) * r);
                dst[64 * j] = w; }
        }
    }
}
template <bool XF>
__device__ __forceinline__ void residual_phase(const Frame& F, const void* xin, const bf16_t* Y, const float* g, bf16_t* XO, float* rstd_out, const float* essq, float* esc) {
    static_assert(!XF, "the residual stream is bf16 between phases");
    for (int m0 = F.gw; m0 < M; m0 += 2 * F.NGW) {
        const int m1 = m0 + F.NGW; const bool has1 = m1 < M; const int m1c = has1 ? m1 : m0;
        const u32x4* yr0 = (const u32x4*)(Y + (size_t)m0 * DM) + F.lane; const u32x4* yr1 = (const u32x4*)(Y + (size_t)m1c * DM) + F.lane;
        const u32x4* xr0 = (const u32x4*)((const bf16_t*)xin + (size_t)m0 * DM) + F.lane; const u32x4* xr1 = (const u32x4*)((const bf16_t*)xin + (size_t)m1c * DM) + F.lane;
        const f32x4* gr = (const f32x4*)g + 2 * F.lane;
        u32x4 ya[8], yb[8], xa[8], xb[8];
#pragma unroll
        for (int j = 0; j < 8; ++j) { ya[j] = yr0[64 * j]; xa[j] = xr0[64 * j]; }
#pragma unroll
        for (int j = 0; j < 8; ++j) { yb[j] = yr1[64 * j]; xb[j] = xr1[64 * j]; }
        float ea = 0.f, eb = 0.f; if (esc) { ea = essq[(size_t)m0 * 64 + F.lane]; eb = essq[(size_t)m1c * 64 + F.lane]; }
#pragma unroll
        for (int rr = 0; rr < 2; ++rr) {
            if (rr == 1 && !has1) break;
            const int m = rr ? m1 : m0; float s = 0.f;
#pragma unroll
            for (int j = 0; j < 8; ++j) { const u32x4 yv = rr ? yb[j] : ya[j];
#pragma unroll
                for (int e = 0; e < 4; ++e) { const float lo = bflo(yv[e]), hi = bfhi(yv[e]); s += lo * lo + hi * hi; } }
            const float ry = 1.0f / sqrtf(wave_sum(s) * (1.0f / DM) + EPS); float s1 = 0.f;
            u32x4* xo = (u32x4*)(XO + (size_t)m * DM) + F.lane;
#pragma unroll
            for (int j = 0; j < 8; ++j) {
                const u32x4 yv = rr ? yb[j] : ya[j], xv = rr ? xb[j] : xa[j];
                const f32x4 g0 = gr[128 * j], g1 = gr[128 * j + 1];
                const f32x4 y0 = {bflo(yv.x), bfhi(yv.x), bflo(yv.y), bfhi(yv.y)}, y1 = {bflo(yv.z), bfhi(yv.z), bflo(yv.w), bfhi(yv.w)};
                const f32x4 x0 = {bflo(xv.x), bfhi(xv.x), bflo(xv.y), bfhi(xv.y)}, x1 = {bflo(xv.z), bfhi(xv.z), bflo(xv.w), bfhi(xv.w)};
                const f32x4 o0 = x0 + y0 * ry * g0, o1 = x1 + y1 * ry * g1;
                s1 += dot4(o0) + dot4(o1);
                u32x4 w; w.x = cvt_pk_bf16(o0[0], o0[1]); w.y = cvt_pk_bf16(o0[2], o0[3]); w.z = cvt_pk_bf16(o1[0], o1[1]); w.w = cvt_pk_bf16(o1[2], o1[3]);
                xo[64 * j] = w;
            }
            if (rstd_out) { const float t = wave_sum(s1); if (F.lane == 0) rstd_out[m] = 1.0f / sqrtf(t * (1.0f / DM) + EPS); }
            if (esc) { const float e = wave_sum(rr ? eb : ea); if (F.lane == 0) esc[m] = 1.0f / sqrtf(e * (1.0f / DM) + EPS); }
        }
    }
}
__device__ __forceinline__ void rstd_phase(const Frame& F, const float* ssq64, float* rstd) {
    for (int m = F.gw; m < M; m += F.NGW) { const float e = wave_sum(ssq64[(size_t)m * 64 + F.lane]); if (F.lane == 0) rstd[m] = 1.0f / sqrtf(e * (1.0f / DM) + EPS); }
}

template <bool MLA, class F2>
__device__ __forceinline__ void attn_phase(const Frame& F, unsigned* qhead, int nunits, const F2& run_unit) {
    LAS char* L = (LAS char*)F.lds; volatile LAS unsigned* uw = (volatile LAS unsigned*)(L + att::OFF_UW);
    for (;;) {
        if (F.tid == 0) *uw = __hip_atomic_fetch_add(qhead, 1u, __ATOMIC_RELAXED, __HIP_MEMORY_SCOPE_AGENT);
        __syncthreads(); const unsigned u = *uw; __syncthreads();
        if (u >= (unsigned)nunits) break;
        run_unit((int)u, L);
    }
}

constexpr int CV_G1_0 = TI_EARLY, CV_G1_1 = TI_EARLY + TI_OUT;
constexpr int CV_AT_0 = CV_G1_1, CV_AT_1 = CV_AT_0 + TI_GU + TI_DN;
constexpr int CV_G3_0 = CV_AT_1, CV_G3_1 = CV_AT_1;
constexpr int CV_G4_0 = CV_G3_1, CV_G4_1 = 2 * TI_LAYER;
static_assert(CV_G4_0 == TI_LAYER - TI_PG, "job order");
constexpr int NPH = 13, N_PHASES = 1 + DEPTH * NPH - 1;

#define P_QA ((bf16_t*)(ws + WS_R1 + R1_QA))
#define P_KA ((bf16_t*)(ws + WS_R1 + R1_KA))
#define P_VA ((bf16_t*)(ws + WS_R1 + R1_VA))
#define P_XR ((bf16_t*)(ws + WS_R1 + R1_XR))
#define P_GG ((bf16_t*)(ws + WS_R1 + R1_GG))
#define P_CQ ((bf16_t*)(ws + WS_R1 + R1_CQ))
#define P_CKV ((bf16_t*)(ws + WS_R1 + R1_CKV))
#define P_KR ((bf16_t*)(ws + WS_R1 + R1_KR))
#define P_QN ((bf16_t*)(ws + WS_R1 + R1_QN))
#define P_QR ((bf16_t*)(ws + WS_R1 + R1_QR))
#define P_XC ((bf16_t*)(ws + WS_R1 + R1_XC))
#define P_ACT ((bf16_t*)(ws + WS_R1))
#define P_KVM ((bf16_t*)(ws + WS_R2 + R2_KVM))
#define P_KRP ((float*)(ws + WS_R2 + R2_END))
#define P_AA ((float*)(ws + WS_R2 + R2_AA))
#define P_BB ((float*)(ws + WS_R2 + R2_BB))
#define P_MO ((bf16_t*)(ws + WS_R2))
#define P_X1 ((bf16_t*)(ws + WS_OC))
#define P_X3 ((bf16_t*)(ws + WS_ERAW + (size_t)M * DM * 2))
#define P_OC ((bf16_t*)(ws + WS_OC))
#define P_MIX ((bf16_t*)(ws + WS_MIX))
#define P_GSS ((float*)(ws + WS_GSS))
#define P_RT ((float*)(ws + WS_RT))
#define P_XB ((bf16_t*)(ws + WS_XB))
#define P_ERAW ((bf16_t*)(ws + WS_ERAW))
#define P_SSQ24 ((float*)(ws + WS_SSQ24))
#define P_SSQ64 ((float*)(ws + WS_SSQ64))
#define P_ESSQ ((float*)(ws + WS_ESSQ))
#define P_RSTD ((float*)(ws + WS_RSTD))
#define P_ESC ((float*)(ws + WS_ESC))
#define P_CP ((float*)(ws + WS_CP))
#define P_CL ((float*)(ws + WS_CL))
#define P_C128 ((const float*)(ws + WS_COS128))
#define P_S128 ((const float*)(ws + WS_SIN128))
#define P_C64 ((const float*)(ws + WS_COS64))
#define P_S64 ((const float*)(ws + WS_SIN64))
#define P_WL(off) ((const bf16_t*)(ws + WS_W + (size_t)l * W_LAYER + (off)))

__global__ void __launch_bounds__(512, 2) fwd(Args a) {
    extern __shared__ __attribute__((aligned(16))) unsigned char lds_raw[];
    Frame F;
    F.lds = (LAS unsigned char*)lds_raw; F.ws = a.ws; F.ctl = (unsigned*)(a.ws + WS_CTL);
    F.tid = threadIdx.x; F.lane = F.tid & 63; F.wave = __builtin_amdgcn_readfirstlane(F.tid >> 6);
    F.G = gridDim.x; { const int bx = blockIdx.x; F.vcu = (F.G % 8 == 0) ? (bx % 8) * (F.G / 8) + bx / 8 : bx; }
    F.gw = F.vcu * 8 + F.wave; F.NGW = F.G * 8;
    volatile LAS unsigned* MISC = (volatile LAS unsigned*)(F.lds + MISC_OFF);
    for (int u = F.tid; u < (LDS_BYTES - RING_BYTES) / 4; u += 512) ((LAS unsigned*)(F.lds + RING_BYTES))[u] = 0u;
    __syncthreads();
    const int lo = a.ph_lo, hi = a.ph_hi;
    XcdBarrier bar; bar.bar = F.ctl + CW_BAR; bar.x = 0; bar.st = nullptr;
    if (hi - lo > 1) bar = xcd_barrier_post(F.ctl + CW_BAR, MISC + 8);
#ifndef PHASE_MASK
#define PHASE_MASK 0xffff
#endif
#define PH_ON(k) (((PHASE_MASK) >> (k)) & 1)
#define IN(k) (lo <= (k) && (k) < hi)
#define SEAM(k) do { if (IN(k) && IN((k) + 1)) xcd_barrier(bar); } while (0)
    const pg8::Prob nullp{nullptr, nullptr, 0, 0, 0, 0, 0};

    if (PH_ON(13) && IN(0)) for (int rep_ = 0; rep_ < REP(13); ++rep_) { F.relane(); prologue(F, a); }
    SEAM(0);
    for (int l = 0; l < DEPTH; ++l) {
        const int pb = 1 + l * NPH;
        if (PH_ON(0) && IN(pb + 0)) for (int rep_ = 0; rep_ < REP(0); ++rep_) {
            F.relane(); unsigned char* ws = F.ws;
            const pg8::Prob P0{l == 0 ? P_XB : P_X3, P_WL(WO_Z), DM, DM, DM, 24, 0};
            const pg8::Prob P1{l == 0 ? P_XB : P_X3, P_WL(WO_KR), DM, 512, 512, 8, 512};
            const pg8::Prob P2{(const bf16_t*)(ws + WS_PB) + (size_t)l * M * PLE, P_WL(WO_PLE), PLE, PLE, PLE, DM / 256, 0};
            pg8::Deal<3> S; S.init(P0, P1, P2, F.G, (int)blockIdx.x);
            const EpiZ E{P_QA, P_KA, P_VA, P_XR, P_GG, P_CQ, P_CKV, P_KRP, P_SSQ24, P_RSTD, P_C128, P_S128, P_ERAW, P_ESSQ};
            const bool cfirst = (blockIdx.x & 1) == 0;
            if (l == 0 && cfirst) { convert_items(F, a, CV_G1_0, CV_G1_1); __syncthreads(); }
            pg8::gemm_phase<3, EpiZ>(F.lds, F.wave, S, E);
            if (l == 0 && !cfirst) { __syncthreads(); convert_items(F, a, CV_G1_0, CV_G1_1); }
        }
        SEAM(pb + 0);
        if (PH_ON(2) && IN(pb + 2)) for (int rep_ = 0; rep_ < REP(2); ++rep_) {
            F.relane(); unsigned char* ws = F.ws;
            const pg8::Prob P0{P_CQ, P_WL(WO_UQ), QRANK, QRANK, QRANK, NQU / 256, 0};
            const pg8::Prob P1{P_CKV, P_WL(WO_UKV), KVRANK, KVRANK, KVRANK, NKVU / 256, 0};
            const pg8::Prob P2{P_XC, P_WL(WO_RG), RGW, 128, 128, 8, 128};
            pg8::Deal<3> S; S.init(P2, P0, P1, F.G, (int)blockIdx.x); S.rev = 8u;
            kr_finish(F, P_KRP, P_C64, P_S64, P_KR);
            { pg8::Unit u; for (int i = 0; pg8::deal_next<3>(S, i, u); ++i) if (u.p == 0) conv_tile(F.tid, u.pm, u.pn, P_XR, (const float*)a.in[I_CONVW] + l * 4 * RGW, (const float*)a.in[I_CONVB] + l * RGW, P_XC); }
            VM_WAIT(); __syncthreads();
            const EpiMid E{EpiUp{P_QN, P_QR, P_KVM, P_SSQ24, P_C64, P_S64}, EpiGate{(const float*)a.in[I_GAB] + l * RGW, (const float*)a.in[I_GXB] + l * RGW, (const float*)(ws + WS_C8) + l * RGW, P_XC, P_AA, P_BB}};
            pg8::gemm_phase<3, EpiMid>(F.lds, F.wave, S, E);
            __syncthreads();
            { pg8::Unit u; for (int i = 0; pg8::deal_next<3>(S, i, u); ++i) if (u.p == 0) scan_pass1_tile(F.tid, u.pm, u.pn, P_AA, P_BB, P_CP, P_CL); }
        }
        SEAM(pb + 2);
        if (PH_ON(4) && IN(pb + 4)) for (int rep_ = 0; rep_ < REP(4); ++rep_) {
            F.relane(); unsigned char* ws = F.ws;
            if (l == 0 && (blockIdx.x & 1) == 0) {
                const int rank = (int)(blockIdx.x >> 1);
                convert_items(F, a, CV_AT_0, CV_AT_1, rank * 8 + F.wave, (F.G / 2) * 8); __syncthreads(); }
            const float* sinks = (const float*)a.in[I_SINK] + l * 12;
            attn_phase<true>(F, F.ctl + CW_Q + 64 * (2 * l + 1 + 4 * rep_), 768, [&](int u, LAS char* L) {
                if (u < 384) {
                    const int qb = 7 - u / 48, rem = u % 48, b = rem / 12, h = rem % 12; const size_t r0 = (size_t)b * SEQ + qb * 256;
                    att::Tens T; T.Q = P_QN + r0 * 1536 + h * 128; T.qp = 1536; T.QR = P_QR + r0 * 768 + h * 64; T.qrp = 768; T.K = P_KVM + (size_t)b * SEQ * NKVU + h * 256; T.kp = NKVU;
                    T.V = T.K + 128; T.vp = NKVU; T.KR = P_KR + (size_t)b * SEQ * 64; T.O = P_OC + r0 * DM + 2560 + h * 128; T.op = DM; T.SS = P_GSS + r0 * 40 + 28 + h;
                    att::attn_unit<true>(L, F.wave, 0u, T, qb * 256, 1 << 30, -1e30f, 0.0f, 0.07216878364870323f);
                } else {
                    const int v = u - 384, b = v / 96, rem = v % 96, h = rem >> 3, qb = rem & 7; const size_t r0 = (size_t)b * SEQ + qb * 256;
                    att::Tens T; T.Q = P_QA + r0 * 1536 + h * 128; T.qp = 1536; T.QR = nullptr; T.qrp = 0; T.K = P_KA + (size_t)b * SEQ * 512 + (h / 3) * 128; T.kp = 512;
                    T.V = P_VA + (size_t)b * SEQ * 512 + (h / 3) * 128; T.vp = 512; T.KR = nullptr; T.O = P_OC + r0 * DM + h * 128; T.op = DM; T.SS = P_GSS + r0 * 40 + h;
                    att::attn_unit<false>(L, F.wave, 0u, T, qb * 256, 128, sinks[h] * 11.313708498984761f, 1.0f, 0.08838834764831845f);
                } });
            scan_pass2(F, P_AA, P_BB, P_CP, P_CL, P_GG, P_OC, P_GSS);
        }
        SEAM(pb + 4);
        if (PH_ON(6) && IN(pb + 6)) for (int rep_ = 0; rep_ < REP(6); ++rep_) {
            F.relane(); unsigned char* ws = F.ws;
            const pg8::Prob P{P_OC, P_WL(WO_OUT), DM, DM, DM, DM / 256, 0};
            pg8::Deal<1> S; S.init(P, nullp, nullp, F.G, (int)blockIdx.x);
            const EpiOut E{P_MO, P_RT};
            { pg8::Unit u; for (int i = 0; pg8::deal_next<1>(S, i, u); ++i) ratio_rows(F.tid, u.pm, P_GSS, P_RT); }
            __syncthreads();
            const bool cfirst = (blockIdx.x & 1) == 0;
            if (l == 0 && cfirst) { convert_items(F, a, CV_G3_0, CV_G3_1); __syncthreads(); }
            pg8::gemm_phase<1, EpiOut>(F.lds, F.wave, S, E);
            if (l == 0 && !cfirst) { __syncthreads(); convert_items(F, a, CV_G3_0, CV_G3_1); }
        }
        SEAM(pb + 6);
        if (PH_ON(7) && IN(pb + 7)) for (int rep_ = 0; rep_ < REP(7); ++rep_) { F.relane(); unsigned char* ws = F.ws;
            if (l == 0) residual_phase<false>(F, P_XB, P_MO, (const float*)a.in[I_POSTMIX] + l * DM, P_X1, P_RSTD, nullptr, nullptr);
            else residual_phase<false>(F, P_X3, P_MO, (const float*)a.in[I_POSTMIX] + l * DM, P_X1, P_RSTD, nullptr, nullptr); }
        SEAM(pb + 7);
        if (PH_ON(8) && IN(pb + 8)) for (int rep_ = 0; rep_ < REP(8); ++rep_) {
            F.relane(); unsigned char* ws = F.ws;
            const pg8::Prob P{P_X1, P_WL(WO_GU), DM, DM, DM, NGU / 256, 0};
            pg8::Deal<1> S; S.init(P, nullp, nullp, F.G, (int)blockIdx.x);
            const EpiGU E{P_ACT, P_RSTD};
            const bool cfirst = (blockIdx.x & 1) == 0;
            if (l == 0 && cfirst) { convert_items(F, a, CV_G4_0, CV_G4_1); __syncthreads(); }
            pg8::gemm_phase<1, EpiGU>(F.lds, F.wave, S, E);
            if (l == 0 && !cfirst) { __syncthreads(); convert_items(F, a, CV_G4_0, CV_G4_1); }
        }
        SEAM(pb + 8);
        if (PH_ON(9) && IN(pb + 9)) for (int rep_ = 0; rep_ < REP(9); ++rep_) {
            F.relane(); unsigned char* ws = F.ws;
            const pg8::Prob P{P_ACT, P_WL(WO_DN), DFF, DFF, DFF, DM / 256, 0};
            pg8::Deal<1> S; S.init(P, nullp, nullp, F.G, (int)blockIdx.x);
            const EpiF32S<true> E{P_MO, nullptr};
            pg8::gemm_phase<1, EpiF32S<true>>(F.lds, F.wave, S, E);
        }
        SEAM(pb + 9);
        if (PH_ON(10) && IN(pb + 10)) for (int rep_ = 0; rep_ < REP(10); ++rep_) { F.relane(); unsigned char* ws = F.ws;
            residual_phase<false>(F, P_X1, P_MO, (const float*)a.in[I_POSTFFN] + l * DM, P_XB, nullptr, P_ESSQ, P_ESC); }
        SEAM(pb + 10);
        if (PH_ON(11) && IN(pb + 11)) for (int rep_ = 0; rep_ < REP(11); ++rep_) {
            F.relane(); unsigned char* ws = F.ws;
            const pg8::Prob P{P_XB, P_WL(WO_PG), DM, DM, DM, DM / 256, 0};
            pg8::Deal<1> S; S.init(P, nullp, nullp, F.G, (int)blockIdx.x);
            if (l + 1 < DEPTH) { const EpiPG<false> E{P_XB, nullptr, rep_ ? P_MIX : P_X3, P_ERAW, P_ESC, (const float*)a.in[I_PLENORM] + l * DM, (const float*)a.in[I_BPG] + l * DM, rep_ ? P_ESSQ : P_SSQ64};
                pg8::gemm_phase<1, EpiPG<false>>(F.lds, F.wave, S, E); }
            else { const EpiPG<true> E{P_XB, a.out, nullptr, P_ERAW, P_ESC, (const float*)a.in[I_PLENORM] + l * DM, (const float*)a.in[I_BPG] + l * DM, nullptr};
                pg8::gemm_phase<1, EpiPG<true>>(F.lds, F.wave, S, E); }
        }
        if (l + 1 < DEPTH) {
            SEAM(pb + 11);
            if (PH_ON(12) && IN(pb + 12)) for (int rep_ = 0; rep_ < REP(12); ++rep_) { F.relane(); unsigned char* ws = F.ws; rstd_phase(F, P_SSQ64, P_RSTD); }
            SEAM(pb + 12);
        }
    }
#undef IN
#undef SEAM
}

extern "C" void kernel_launch(void* const* d_in, const int* in_sizes, int n_in, void* d_out, int out_size, void* d_ws, size_t ws_size, hipStream_t stream) {
    static int grid = 0;
    if (grid == 0) {
        if (n_in != NIN || out_size != M * DM || ws_size < WS_END) { fprintf(stderr, "kernel_launch: unexpected shapes (n_in %d, out %d, ws %zu < %zu)\n", n_in, out_size, ws_size, (size_t)WS_END); grid = -1; return; }
        int dev = 0, cus = 0, per_cu = 0;
        if (hipGetDevice(&dev) != hipSuccess || hipDeviceGetAttribute(&cus, hipDeviceAttributeMultiprocessorCount, dev) != hipSuccess) { grid = -1; return; }
        if (hipFuncSetAttribute((const void*)fwd, hipFuncAttributeMaxDynamicSharedMemorySize, LDS_BYTES) != hipSuccess) { fprintf(stderr, "kernel_launch: hipFuncSetAttribute failed\n"); grid = -1; return; }
        if (hipOccupancyMaxActiveBlocksPerMultiprocessor(&per_cu, (const void*)fwd, 512, LDS_BYTES) != hipSuccess || per_cu < 1) fprintf(stderr, "kernel_launch: occupancy query says %d\n", per_cu);
        (void)hipGetLastError();
        grid = cus;
    }
    if (grid < 0) return;
    (void)in_sizes;
    if (hipMemsetAsync((char*)d_ws + WS_CTL, 0, CTL_BYTES, stream) != hipSuccess) return;
    Args a{};
    for (int i = 0; i < NIN; ++i) a.in[i] = d_in[i];
    a.out = (float*)d_out; a.ws = (unsigned char*)d_ws;
    for (int i = 0; i < 64; ++i) a.inv128[i] = (float)pow(10000.0, -(double)i / 64.0);
    for (int i = 0; i < 32; ++i) a.inv64[i] = (float)pow(10000.0, -(double)i / 32.0);
#if MK_N_LAUNCHES == 1
    a.ph_lo = 0; a.ph_hi = N_PHASES;
    hipLaunchKernelGGL(fwd, dim3(grid), dim3(512), LDS_BYTES, stream, a);
#else
    for (int ph = 0; ph < N_PHASES; ++ph) { a.ph_lo = ph; a.ph_hi = ph + 1; hipLaunchKernelGGL(fwd, dim3(grid), dim3(512), LDS_BYTES, stream, a); }
#endif
}
```
